# Optimizing an MI355X kernel written in HIP

```python
import math
import jax
import jax.numpy as jnp
from jax import lax
import numpy as np

D_MODEL = 1024
BATCH = 8
SEQ = 4096
DEPTH = 2

GRID_W = 64
CTX_LEN = 256
N_EVEN = (DEPTH + 1) // 2
N_ODD = DEPTH // 2
NORM_EPS = 1e-6
CONV_W = 3
CHUNK = 64
SC_WIDTH = 1024
SSD_HEADS = 16
SSD_HEAD_DIM = 64
SSD_WIDTH = SSD_HEADS * SSD_HEAD_DIM
SSD_GROUPS = 4
SSD_STATE = 128
SSD_CONV_DIM = SSD_WIDTH + 2 * SSD_GROUPS * SSD_STATE
EVEN_IN = 3 * SC_WIDTH + SSD_WIDTH + SSD_CONV_DIM + 2 * SSD_HEADS
EVEN_MIX = SC_WIDTH + SSD_WIDTH
HG_EXPAND = 128
HG_HEADS = D_MODEL // HG_EXPAND
HG_KDIM = HG_EXPAND
HG_VDIM = D_MODEL // HG_HEADS
HG_FWIDTH = HG_HEADS * HG_KDIM
HG_IWIDTH = HG_HEADS * HG_VDIM
ODD_IN = 3 * HG_FWIDTH + 2 * HG_IWIDTH
PEER_HEADS = 8
PEER_NKEYS = 128
PEER_EXPERTS = PEER_NKEYS * PEER_NKEYS
PEER_QDIM = 256
PEER_HALF = PEER_QDIM // 2
PEER_TOPK = 16
PEER_BLOCK = 128

kernel_name = "hybrid_conv_ssd_hgrn2_peer_dit"


def rmsnorm(x, w):
    xf = x.astype(jnp.float32)
    y = xf * lax.rsqrt(jnp.mean(xf * xf, axis=-1, keepdims=True) + NORM_EPS)
    return (y * w.astype(jnp.float32)).astype(x.dtype)


def group_rmsnorm(y, w, groups):
    shp = y.shape
    yg = y.astype(jnp.float32).reshape(*shp[:-1], groups, shp[-1] // groups)
    yg = yg * lax.rsqrt(jnp.mean(yg * yg, axis=-1, keepdims=True) + NORM_EPS)
    return yg.reshape(shp) * w.astype(jnp.float32)


def modulate(h, shift, scale):
    return h * (1 + scale) + shift


def dwconv(u, w):
    L = u.shape[1]
    pad = CONV_W // 2
    up = jnp.pad(u, ((0, 0), (pad, pad), (0, 0)))
    return sum(up[:, k:k + L] * w[k] for k in range(CONV_W))


def conv_grid(u, w):
    Bsz, S, C = u.shape
    rows = S // GRID_W
    return dwconv(u.reshape(Bsz * rows, GRID_W, C), w).reshape(Bsz, S, C)


def chunk_scan(decay, contrib, s0, keep_starts):
    def step(s, inp):
        d, u = inp
        return d * s + u, (s if keep_starts else None)
    s_fin, starts = lax.scan(step, s0, (jnp.moveaxis(decay, 1, 0), jnp.moveaxis(contrib, 1, 0)))
    return (jnp.moveaxis(starts, 0, 1) if keep_starts else None), s_fin


def ssd_scan(xh, dt, a, bm, cm, s0, with_out):
    Bsz, T, H, P = xh.shape
    G, N = bm.shape[2], bm.shape[3]
    hpg = H // G
    nc = T // CHUNK
    xdt = (xh * dt[..., None]).reshape(Bsz, nc, CHUNK, G, hpg, P)
    bm = bm.reshape(Bsz, nc, CHUNK, G, N)
    la = jnp.cumsum((dt * a).reshape(Bsz, nc, CHUNK, G, hpg), axis=2)
    to_end = jnp.exp(la[:, :, -1:] - la)
    contrib = jnp.einsum('bcsgn,bcsgh,bcsghp->bcghnp', bm, to_end, xdt).reshape(Bsz, nc, H, N, P)
    chunk_decay = jnp.exp(la[:, :, -1]).reshape(Bsz, nc, H, 1, 1)
    starts, s_fin = chunk_scan(chunk_decay, contrib, s0, with_out)
    if not with_out:
        return None, s_fin
    cm = cm.reshape(Bsz, nc, CHUNK, G, N)
    mask = jnp.tril(jnp.ones((CHUNK, CHUNK), dtype=bool))[:, :, None, None]
    seg = la[:, :, :, None] - la[:, :, None]
    lmat = jnp.exp(jnp.where(mask, seg, -jnp.inf))
    cb = jnp.einsum('bctgn,bcsgn->bctsg', cm, bm)
    y = jnp.einsum('bctsg,bctsgh,bcsghp->bctghp', cb, lmat, xdt)
    y = y + jnp.einsum('bctgn,bcghnp,bctgh->bctghp', cm, starts.reshape(Bsz, nc, G, hpg, N, P), jnp.exp(la))
    return y.reshape(Bsz, T, H, P), s_fin


def gla_scan(q, k, v, g, s0, with_out):
    Bsz, T, H, K = q.shape
    V = v.shape[-1]
    nc = T // CHUNK
    q = q.reshape(Bsz, nc, CHUNK, H, K)
    k = k.reshape(Bsz, nc, CHUNK, H, K)
    v = v.reshape(Bsz, nc, CHUNK, H, V)
    gc = jnp.cumsum(g.reshape(Bsz, nc, CHUNK, H, K), axis=2)
    g_end = gc[:, :, -1]
    contrib = jnp.einsum('bcshk,bcshv->bchkv', k * jnp.exp(g_end[:, :, None] - gc), v)
    starts, s_fin = chunk_scan(jnp.exp(g_end)[..., None], contrib, s0, with_out)
    if not with_out:
        return None, s_fin
    qg = q * jnp.exp(gc)
    kg = k * jnp.exp(-gc)
    mask = jnp.tril(jnp.ones((CHUNK, CHUNK), dtype=bool))
    att = jnp.where(mask, jnp.einsum('bcthk,bcshk->bchts', qg, kg), 0.0)
    o = jnp.einsum('bchts,bcshv->bcthv', att, v) + jnp.einsum('bcthk,bchkv->bcthv', qg, starts)
    return o.reshape(Bsz, T, H, V), s_fin


def _flipper(d):
    return (lambda t: jnp.flip(t, axis=1)) if d == 1 else (lambda t: t)


def even_mixer(hx, hc, w_in, w_out, sc_conv_w, ssd_conv_w, ssd_conv_b, dt_bias, a_log, d_skip,
               ssd_norm_w, need_ctx):
    a = -jnp.exp(a_log.astype(jnp.float32))
    dt_bias = dt_bias.astype(jnp.float32)

    def project(h, conv):
        Bsz, T, _ = h.shape
        sc_x, sc_b, sc_c, z, xbc, dt_raw = jnp.split(
            h @ w_in,
            [SC_WIDTH, 2 * SC_WIDTH, 3 * SC_WIDTH, 3 * SC_WIDTH + SSD_WIDTH,
             3 * SC_WIDTH + SSD_WIDTH + SSD_CONV_DIM], axis=-1)
        xbc = jax.nn.silu(conv(xbc, ssd_conv_w) + ssd_conv_b).astype(jnp.float32)
        xs, bm, cm = jnp.split(xbc, [SSD_WIDTH, SSD_WIDTH + SSD_GROUPS * SSD_STATE], axis=-1)
        ssd_in = (xs.reshape(Bsz, T, SSD_HEADS, SSD_HEAD_DIM),
                  bm.reshape(Bsz, T, SSD_GROUPS, SSD_STATE),
                  cm.reshape(Bsz, T, SSD_GROUPS, SSD_STATE),
                  dt_raw.astype(jnp.float32).reshape(Bsz, T, 2, SSD_HEADS))
        return (sc_x, sc_b, sc_c, z), ssd_in

    def run(ssd_in, d, s0, with_out):
        xs, bm, cm, dt_raw = ssd_in
        dt = jax.nn.softplus(dt_raw[:, :, d] + dt_bias[d])
        fl = _flipper(d)
        y, s = ssd_scan(fl(xs), fl(dt), a[d], fl(bm), fl(cm), s0, with_out)
        return (fl(y) if with_out else None), s

    def finish(gates, ssd_in, y_ssd, conv):
        sc_x, sc_b, sc_c, z = gates
        Bsz, T = z.shape[:2]
        y_a = sc_b * conv(sc_c * sc_x, sc_conv_w)
        y_b = (y_ssd + d_skip.astype(jnp.float32)[:, None] * ssd_in[0]).reshape(Bsz, T, SSD_WIDTH)
        y_b = group_rmsnorm(y_b * jax.nn.silu(z.astype(jnp.float32)), ssd_norm_w, SSD_GROUPS)
        return jnp.concatenate([y_a, y_b.astype(y_a.dtype)], axis=-1) @ w_out

    gates_x, ssd_x = project(hx, conv_grid)
    gates_c, ssd_c = project(hc, dwconv)
    Bsz = hx.shape[0]
    ys_x, ys_c = [], []
    for d in range(2):
        s0 = jnp.zeros((Bsz, SSD_HEADS, SSD_STATE, SSD_HEAD_DIM), jnp.float32)
        yc_d, s_ctx = run(ssd_c, d, s0, need_ctx)
        yx_d, _ = run(ssd_x, d, s_ctx, True)
        ys_x.append(yx_d)
        ys_c.append(yc_d)
    out_x = finish(gates_x, ssd_x, ys_x[0] + ys_x[1], conv_grid)
    out_c = finish(gates_c, ssd_c, ys_c[0] + ys_c[1], dwconv) if need_ctx else None
    return out_x, out_c


def odd_mixer(hx, hc, w_in, w_out, lower_bound, norm_w, need_ctx):
    lb = lower_bound.reshape(2, 1, 1, HG_HEADS, HG_KDIM)

    def project(h):
        Bsz, T, _ = h.shape
        q, f_fwd, f_bwd, i, g = jnp.split(
            h @ w_in, [HG_FWIDTH, 2 * HG_FWIDTH, 3 * HG_FWIDTH, 3 * HG_FWIDTH + HG_IWIDTH], axis=-1)
        heads = lambda t, dim: t.astype(jnp.float32).reshape(Bsz, T, HG_HEADS, dim)
        q = heads(jax.nn.silu(q), HG_KDIM) * (HG_KDIM ** -0.5)
        return q, (heads(f_fwd, HG_KDIM), heads(f_bwd, HG_KDIM)), heads(i, HG_VDIM), g

    def run(p, d, s0, with_out):
        q, fs, i, _ = p
        f = lb[d] + (1.0 - lb[d]) * jax.nn.sigmoid(fs[d])
        fl = _flipper(d)
        o, s = gla_scan(fl(q), fl(1.0 - f), fl(i), fl(jnp.log(f)), s0, with_out)
        return (fl(o) if with_out else None), s

    def finish(o, g):
        Bsz, T = g.shape[:2]
        o = group_rmsnorm(o.reshape(Bsz, T, HG_IWIDTH), norm_w, HG_HEADS) * jax.nn.silu(g.astype(jnp.float32))
        return o.astype(g.dtype) @ w_out

    lat, cp = project(hx), project(hc)
    Bsz = hx.shape[0]
    os_x, os_c = [], []
    for d in range(2):
        s0 = jnp.zeros((Bsz, HG_HEADS, HG_KDIM, HG_VDIM), jnp.float32)
        oc_d, s_ctx = run(cp, d, s0, need_ctx)
        ox_d, _ = run(lat, d, s_ctx, True)
        os_x.append(ox_d)
        os_c.append(oc_d)
    out_x = finish(os_x[0] + os_x[1], lat[3])
    out_c = finish(os_c[0] + os_c[1], cp[3]) if need_ctx else None
    return out_x, out_c


def peer_ffn(h, wq, keys, u_tab, v_tab):
    Bsz, T, D = h.shape
    n = Bsz * T
    hf = h.reshape(n, D)
    q = (hf @ wq).reshape(n, PEER_HEADS, 2, PEER_HALF)
    sub = jnp.einsum('nhad,hakd->nhak', q, keys)
    s_top, i_top = lax.top_k(sub, PEER_TOPK)
    cand_s = (s_top[:, :, 0, :, None] + s_top[:, :, 1, None, :]).reshape(n, PEER_HEADS, PEER_TOPK * PEER_TOPK)
    cand_i = (i_top[:, :, 0, :, None] * PEER_NKEYS + i_top[:, :, 1, None, :]).reshape(n, PEER_HEADS, PEER_TOPK * PEER_TOPK)
    best_s, pos = lax.top_k(cand_s, PEER_TOPK)
    idx = jnp.take_along_axis(cand_i, pos, axis=-1)
    gate = jax.nn.softmax(best_s.astype(jnp.float32), axis=-1).astype(h.dtype)
    nb = n // PEER_BLOCK
    idx = idx.reshape(nb, PEER_BLOCK, PEER_HEADS * PEER_TOPK)
    gate = gate.reshape(nb, PEER_BLOCK, PEER_HEADS * PEER_TOPK)

    def block(args):
        hb, ib, gb = args
        act = jax.nn.gelu(jnp.einsum('td,tkd->tk', hb, u_tab[ib]), approximate=False) * gb
        return jnp.einsum('tk,tkd->td', act, v_tab[ib])

    out = lax.map(block, (hf.reshape(nb, PEER_BLOCK, D), idx, gate))
    return out.reshape(Bsz, T, D)


def setup_inputs(seed: int = 0) -> dict:
    key = jax.random.key(seed)
    ks = iter(jax.random.split(key, 32))
    nrm = lambda shape, scale: jax.random.normal(next(ks), shape, jnp.float32) * scale
    gain = lambda shape: 1.0 + 0.02 * jax.random.normal(next(ks), shape, jnp.float32)
    D = D_MODEL
    x = nrm((BATCH, SEQ, D), 1.0)
    c = nrm((BATCH, D), 1.0)
    ctx = nrm((BATCH, CTX_LEN, D), 1.0)
    c_ctx = nrm((D,), 1.0)
    ada_w = nrm((DEPTH, D, 6 * D), 0.5 * D ** -0.5)
    ada_b = nrm((DEPTH, 6 * D), 0.02)
    norm_mix_w = gain((DEPTH, D))
    norm_ffn_w = gain((DEPTH, D))
    norm_f_w = gain((D,))
    ev_w_in = nrm((N_EVEN, D, EVEN_IN), D ** -0.5)
    ev_w_out = nrm((N_EVEN, EVEN_MIX, D), EVEN_MIX ** -0.5)
    sc_conv_w = nrm((N_EVEN, CONV_W, SC_WIDTH), CONV_W ** -0.5)
    ssd_conv_w = nrm((N_EVEN, CONV_W, SSD_CONV_DIM), CONV_W ** -0.5)
    ssd_conv_b = nrm((N_EVEN, SSD_CONV_DIM), 0.02)
    log_dt = jax.random.uniform(next(ks), (N_EVEN, 2, SSD_HEADS), jnp.float32, math.log(1e-3), math.log(1e-1))
    dt0 = jnp.exp(log_dt)
    ssd_dt_bias = dt0 + jnp.log(-jnp.expm1(-dt0))
    ssd_a_log = jnp.log(jax.random.uniform(next(ks), (N_EVEN, 2, SSD_HEADS), jnp.float32, 1.0, 16.0))
    ssd_d = gain((N_EVEN, SSD_HEADS))
    ssd_norm_w = gain((N_EVEN, SSD_WIDTH))
    od_w_in = nrm((N_ODD, D, ODD_IN), D ** -0.5)
    od_w_out = nrm((N_ODD, HG_IWIDTH, D), HG_IWIDTH ** -0.5)
    hg_lb_logits = 1.0 + nrm((DEPTH, 2, HG_FWIDTH), 0.1)
    hg_norm_w = gain((N_ODD, HG_IWIDTH))
    peer_wq = nrm((DEPTH, D, PEER_HEADS * PEER_QDIM), D ** -0.5)
    peer_keys = nrm((DEPTH, PEER_HEADS, 2, PEER_NKEYS, PEER_HALF), PEER_HALF ** -0.5)
    peer_u = nrm((DEPTH, PEER_EXPERTS, D), D ** -0.5)
    peer_v = nrm((DEPTH, PEER_EXPERTS, D), 0.5)
    return {"x": x, "c": c, "ctx": ctx, "c_ctx": c_ctx, "ada_w": ada_w, "ada_b": ada_b,
            "norm_mix_w": norm_mix_w, "norm_ffn_w": norm_ffn_w, "norm_f_w": norm_f_w,
            "ev_w_in": ev_w_in, "ev_w_out": ev_w_out, "sc_conv_w": sc_conv_w,
            "ssd_conv_w": ssd_conv_w, "ssd_conv_b": ssd_conv_b, "ssd_dt_bias": ssd_dt_bias,
            "ssd_a_log": ssd_a_log, "ssd_d": ssd_d, "ssd_norm_w": ssd_norm_w,
            "od_w_in": od_w_in, "od_w_out": od_w_out, "hg_lb_logits": hg_lb_logits,
            "hg_norm_w": hg_norm_w, "peer_wq": peer_wq, "peer_keys": peer_keys,
            "peer_u": peer_u, "peer_v": peer_v}


def reference(x, c, ctx, c_ctx, ada_w, ada_b, norm_mix_w, norm_ffn_w, norm_f_w, ev_w_in, ev_w_out,
              sc_conv_w, ssd_conv_w, ssd_conv_b, ssd_dt_bias, ssd_a_log, ssd_d, ssd_norm_w,
              od_w_in, od_w_out, hg_lb_logits, hg_norm_w, peer_wq, peer_keys, peer_u, peer_v):
    lb_sm = jax.nn.softmax(hg_lb_logits.astype(jnp.float32), axis=0)
    lower_bounds = jnp.cumsum(lb_sm, axis=0) - lb_sm[0]
    cond_x = jax.nn.silu(c)[:, None, :]
    cond_c = jax.nn.silu(c_ctx)
    for layer in range(DEPTH):
        last = layer == DEPTH - 1
        j = layer // 2
        mx = jnp.split(cond_x @ ada_w[layer] + ada_b[layer], 6, axis=-1)
        mc = jnp.split(cond_c @ ada_w[layer] + ada_b[layer], 6, axis=-1)
        hx = modulate(rmsnorm(x, norm_mix_w[layer]), mx[0], mx[1])
        hc = modulate(rmsnorm(ctx, norm_mix_w[layer]), mc[0], mc[1])
        if layer % 2 == 0:
            ox, oc = even_mixer(hx, hc, ev_w_in[j], ev_w_out[j], sc_conv_w[j], ssd_conv_w[j],
                                ssd_conv_b[j], ssd_dt_bias[j], ssd_a_log[j], ssd_d[j], ssd_norm_w[j],
                                not last)
        else:
            ox, oc = odd_mixer(hx, hc, od_w_in[j], od_w_out[j], lower_bounds[layer], hg_norm_w[j],
                               not last)
        x = x + mx[2] * ox
        x = x + mx[5] * peer_ffn(modulate(rmsnorm(x, norm_ffn_w[layer]), mx[3], mx[4]),
                                 peer_wq[layer], peer_keys[layer], peer_u[layer], peer_v[layer])
        if not last:
            ctx = ctx + mc[2] * oc
            ctx = ctx + mc[5] * peer_ffn(modulate(rmsnorm(ctx, norm_ffn_w[layer]), mc[3], mc[4]),
                                         peer_wq[layer], peer_keys[layer], peer_u[layer], peer_v[layer])
    return rmsnorm(x, norm_f_w)
```

```cpp
#define MK_ONE_LAUNCH 0
#include <hip/hip_runtime.h>
#include <stdint.h>
#include <cstdio>

#define LAS __attribute__((address_space(3)))
typedef unsigned short u16;
typedef float f32x2 __attribute__((ext_vector_type(2)));
typedef unsigned u32x2 __attribute__((ext_vector_type(2)));
typedef __bf16 bf16v2 __attribute__((ext_vector_type(2)));

constexpr int D = 1024, NB = 8, SEQ = 4096, CTXL = 256;
constexpr int ML = NB * SEQ;
constexpr int MC = NB * CTXL;
constexpr int MA = ML + MC;
constexpr int EVEN_IN = 6176, ODD_IN = 5120;
constexpr int NIN0 = 6400;
constexpr float NORM_EPS = 1e-6f;

namespace pg8 {
#define PG8_LAS __attribute__((address_space(3)))
typedef unsigned short bf16_t;
typedef short bf16x8 __attribute__((ext_vector_type(8)));
typedef float f32x4 __attribute__((ext_vector_type(4)));
typedef unsigned u32x4 __attribute__((ext_vector_type(4)));
constexpr int BM = 256, BK = 64, HALF = 128, HTB = HALF * BK * 2  , STAGE_BYTES = 8 * HTB, NXCD = 8, WGM = 8;

__host__ __device__ __forceinline__ int lds_byte(int r, int c) { const int st = (r >> 4) * 2 + (c >> 5), rr = r & 15, cc = c & 31, ob = rr * 64 + cc * 2; return st * 1024 + (ob ^ (((ob >> 9) & 1) << 5)); }
__host__ __device__ __forceinline__ void stage_rc(int b, int& R, int& C) { const int st = b / 1024, sb = b % 1024, swz = sb ^ (((sb >> 9) & 1) << 5); R = (st >> 1) * 16 + swz / 64; C = (st & 1) * 32 + (swz % 64) / 2; }
__host__ __device__ __forceinline__ int perm32(int rho) { const int n = rho >> 4, i = rho & 15; return 8 * (i >> 2) + 4 * n + (i & 3); }

struct Unit { int pm, pn; };
struct Gemm { const bf16_t* A; const bf16_t* Bt; int M, N, K; };

struct StaticOrder {
    int nM, nN, nwg, G, c;
    __host__ __device__ void init(int M, int N, int G_, int c_) { nM = M / BM; nN = N / BM; nwg = nM * nN; G = G_; c = c_; }
    __host__ __device__ bool next(int i, Unit& u) const {
        const long L = (long)i * G + c; if (L >= nwg) return false;
        int wgid = (int)L; { const int q = nwg / NXCD, r = nwg % NXCD, xcd = wgid % NXCD, off = wgid / NXCD; wgid = (xcd < r ? xcd * (q + 1) : r * (q + 1) + (xcd - r) * q) + off; }
        const int nig = WGM * nN, gid = wgid / nig, fm = gid * WGM, gsz = (nM - fm) < WGM ? (nM - fm) : WGM;
        u.pm = fm + ((wgid % nig) % gsz); u.pn = (wgid % nig) / gsz; return true;
    }
    __device__ __forceinline__ void a_ready(const Unit&) const {}
    __device__ __forceinline__ void done(const Unit&) const {}
};


template <class Epi, class Sched>
__device__ __forceinline__ void gemm_phase(PG8_LAS unsigned char* lds, const Gemm g, const Sched& S, const Epi& E) {
    const int tid = threadIdx.x, wid = __builtin_amdgcn_readfirstlane(tid >> 6), lane = tid & 63, wr = wid >> 2, wc = wid & 3, fr = lane & 15, fq = lane >> 4;
    const int K = g.K, nt = K / BK;
    unsigned voffA[2], voffB[2];
#pragma unroll
    for (int i = 0; i < 2; ++i) { int R, C; stage_rc(tid * 16 + i * 8192, R, C); const int Rb = Epi::PERM ? ((R & ~31) + perm32(R & 31)) : R;
        voffA[i] = (unsigned)(R * K + C) * 2u; voffB[i] = (unsigned)(Rb * K + C) * 2u; }
    const size_t kstep = (size_t)(BK * 2);
    const size_t hstep = (size_t)HALF * K * 2;
    const size_t tstep = 2 * hstep;
    const unsigned ldsw = (unsigned)wid * 1024u;
    const int aoff = lds_byte(wr * 64 + fr, fq * 8), boff = lds_byte(wc * 32 + fr, fq * 8);
#define PG8_SA(b, h) (((b) * 2 + (h)) * HTB)
#define PG8_SB(b, h) ((4 + (b) * 2 + (h)) * HTB)
#define PG8_STAGE(bufoff, gbase, voff) do { _Pragma("unroll") for (int _i = 0; _i < 2; ++_i) \
        __builtin_amdgcn_global_load_lds((const unsigned*)((const char*)(gbase) + (voff)[_i]), (PG8_LAS unsigned*)(lds + (bufoff) + ldsw + _i * 8192), 16, 0, 0); } while (0)
#define PG8_LDA(dst, b, h) do { _Pragma("unroll") for (int m = 0; m < 4; ++m) _Pragma("unroll") for (int k = 0; k < 2; ++k) dst[m][k] = *(const PG8_LAS bf16x8*)(lds + PG8_SA(b, h) + aoff + m * 2048 + k * 1024); } while (0)
#define PG8_LDB(dst, b, h) do { _Pragma("unroll") for (int n = 0; n < 2; ++n) _Pragma("unroll") for (int k = 0; k < 2; ++k) dst[n][k] = *(const PG8_LAS bf16x8*)(lds + PG8_SB(b, h) + boff + n * 2048 + k * 1024); } while (0)
#define PG8_MMA(ai, bj, At, Bt) do { __builtin_amdgcn_s_setprio(1); _Pragma("unroll") for (int m = 0; m < 4; ++m) _Pragma("unroll") for (int n = 0; n < 2; ++n) _Pragma("unroll") for (int k = 0; k < 2; ++k) \
        acc[ai][bj][m][n] = __builtin_amdgcn_mfma_f32_16x16x32_bf16(Bt[n][k], At[m][k], acc[ai][bj][m][n], 0, 0, 0); __builtin_amdgcn_s_setprio(0); } while (0)
#define PG8_WAIT_V(n) asm volatile("s_waitcnt vmcnt(" #n ")" ::: "memory")
#define PG8_WAIT_L(n) asm volatile("s_waitcnt lgkmcnt(" #n ")" ::: "memory")
#define PG8_BAR __builtin_amdgcn_s_barrier()
#define PG8_SCHED __builtin_amdgcn_sched_barrier(0)
    Unit cur, nxt; int ui = 0;
    if (!S.next(0, cur)) return;
    f32x4 acc[2][2][4][2];
#pragma unroll
    for (int a = 0; a < 2; ++a)
#pragma unroll
        for (int b = 0; b < 2; ++b)
#pragma unroll
            for (int m = 0; m < 4; ++m)
#pragma unroll
                for (int n = 0; n < 2; ++n) acc[a][b][m][n] = (f32x4){0.f, 0.f, 0.f, 0.f};
    bf16x8 At[4][2], B0[2][2], B1[2][2];
    const char* cA = (const char*)g.A + (size_t)cur.pm * tstep; const char* cB = (const char*)g.Bt + (size_t)cur.pn * tstep;
    S.a_ready(cur);
    PG8_STAGE(PG8_SB(0, 0), cB, voffB); PG8_STAGE(PG8_SA(0, 0), cA, voffA); PG8_STAGE(PG8_SB(0, 1), cB + hstep, voffB); PG8_STAGE(PG8_SA(0, 1), cA + hstep, voffA);
    if (wr == 1) PG8_BAR;
    PG8_WAIT_V(4); PG8_BAR;
    PG8_STAGE(PG8_SB(1, 0), cB + kstep, voffB); PG8_STAGE(PG8_SA(1, 0), cA + kstep, voffA); PG8_STAGE(PG8_SB(1, 1), cB + hstep + kstep, voffB);
    PG8_WAIT_V(6); PG8_BAR;
    for (;;) {
        const bool has_next = S.next(ui + 1, nxt);
        const char* nA = has_next ? (const char*)g.A + (size_t)nxt.pm * tstep : cA; const char* nB = has_next ? (const char*)g.Bt + (size_t)nxt.pn * tstep : cB;
        for (int t = 0; t < nt; t += 2) {
            const bool last = (t == nt - 2);
            const char* a1 = cA + (size_t)(t + 1) * kstep;
            const char* a2 = last ? nA : cA + (size_t)(t + 2) * kstep; const char* b2 = last ? nB : cB + (size_t)(t + 2) * kstep;
            const char* a3 = a2 + kstep; const char* b3 = b2 + kstep;
            if (last && has_next) S.a_ready(nxt);
            PG8_LDB(B0, 0, 0); PG8_SCHED; PG8_LDA(At, 0, 0); PG8_STAGE(PG8_SA(1, 1), a1 + hstep, voffA);
            PG8_WAIT_L(8); PG8_BAR; PG8_WAIT_L(0); PG8_MMA(0, 0, At, B0); PG8_BAR; PG8_SCHED;
            PG8_LDB(B1, 0, 1); PG8_STAGE(PG8_SB(0, 0), b2, voffB);
            PG8_BAR; PG8_WAIT_L(0); PG8_MMA(0, 1, At, B1); PG8_BAR;
            PG8_LDA(At, 0, 1); PG8_STAGE(PG8_SA(0, 0), a2, voffA);
            PG8_BAR; PG8_WAIT_L(0); PG8_MMA(1, 0, At, B0); PG8_BAR; PG8_SCHED;
            PG8_STAGE(PG8_SB(0, 1), b2 + hstep, voffB);
            PG8_WAIT_V(6); PG8_BAR; PG8_MMA(1, 1, At, B1); PG8_BAR;
            PG8_LDB(B0, 1, 0); PG8_SCHED; PG8_LDA(At, 1, 0); PG8_STAGE(PG8_SA(0, 1), a2 + hstep, voffA);
            PG8_WAIT_L(8); PG8_BAR; PG8_WAIT_L(0); PG8_MMA(0, 0, At, B0); PG8_BAR; PG8_SCHED;
            PG8_LDB(B1, 1, 1); PG8_STAGE(PG8_SB(1, 0), b3, voffB);
            PG8_BAR; PG8_WAIT_L(0); PG8_MMA(0, 1, At, B1); PG8_BAR;
            PG8_LDA(At, 1, 1); PG8_STAGE(PG8_SA(1, 0), a3, voffA);
            PG8_BAR; PG8_WAIT_L(0); PG8_MMA(1, 0, At, B0); PG8_BAR; PG8_SCHED;
            PG8_STAGE(PG8_SB(1, 1), b3 + hstep, voffB);
            PG8_WAIT_V(6); PG8_BAR; PG8_MMA(1, 1, At, B1); PG8_BAR;
        }
        if constexpr (!Epi::AFTER_DRAIN) { E(acc, cur, wr, wc, fr, fq); S.done(cur); }
        if (!has_next) break;
#pragma unroll
        for (int a = 0; a < 2; ++a)
#pragma unroll
            for (int b = 0; b < 2; ++b)
#pragma unroll
                for (int m = 0; m < 4; ++m)
#pragma unroll
                    for (int n = 0; n < 2; ++n) acc[a][b][m][n] = (f32x4){0.f, 0.f, 0.f, 0.f};
        cur = nxt; cA = nA; cB = nB; ++ui;
    }
    PG8_WAIT_V(0);
    if (wr == 0) PG8_BAR;
    PG8_BAR;
    if constexpr (Epi::AFTER_DRAIN) { E.fused(acc, cur, wr, wc, fr, fq, lds, wid, lane); S.done(cur); }
#undef PG8_SA
#undef PG8_SB
#undef PG8_STAGE
#undef PG8_LDA
#undef PG8_LDB
#undef PG8_MMA
#undef PG8_WAIT_V
#undef PG8_WAIT_L
#undef PG8_BAR
#undef PG8_SCHED
}
}

using pg8::bf16_t; using pg8::bf16x8; using pg8::f32x4; using pg8::u32x4;

#define XB_TMO      128
#define XB_XCNT(j)  (256  + 64 * (j))
#define XB_XSUB(j)  (1280 + 64 * (j))
#define XB_XGEN(j)  (2304 + 64 * (j))
#define XB_TOP      3328
#define XB_TOPGEN   3392
#define XCD_BAR_WORDS 3456
#define XB_SPIN_CAP (1u << 18)

__device__ __forceinline__ unsigned xb_ld(unsigned* p)              { return __hip_atomic_load(p, __ATOMIC_RELAXED, __HIP_MEMORY_SCOPE_AGENT); }
__device__ __forceinline__ unsigned xb_add(unsigned* p, unsigned v) { return __hip_atomic_fetch_add(p, v, __ATOMIC_RELAXED, __HIP_MEMORY_SCOPE_AGENT); }
__device__ __forceinline__ unsigned xb_xcc_id() { return (unsigned)__builtin_amdgcn_s_getreg((3 << 11) | 20) & 0xFu; }
#define XB_SPIN(cond, bar) do { unsigned _sp = 0; while (cond) { __builtin_amdgcn_s_sleep(1); \
    if ((++_sp & 255u) == 0u) { if (xb_ld(&(bar)[XB_TMO])) break; if (_sp > XB_SPIN_CAP) { atomicAdd(&(bar)[XB_TMO], 1u); break; } } } } while (0)

struct XcdBarrier {
    unsigned* bar; unsigned x;
    volatile LAS unsigned* st;
};

__device__ __forceinline__ XcdBarrier xcd_barrier_post(unsigned* bar, volatile LAS unsigned* st) {
    XcdBarrier b; b.bar = bar; b.x = xb_xcc_id(); b.st = st;
    if (threadIdx.x == 0) (void)xb_add(&bar[XB_XCNT(b.x)], 1u);
    return b;
}
__device__ __forceinline__ void xcd_barrier_complete(unsigned* bar, unsigned x, unsigned& nloc, unsigned& nx) {
    const unsigned G = gridDim.x * gridDim.y * gridDim.z;
    unsigned sum, cnt, mine, sp = 0u;
    for (;;) {
        sum = 0u; cnt = 0u; mine = 0u;
#pragma unroll
        for (unsigned j = 0; j < 16; ++j) { const unsigned c = xb_ld(&bar[XB_XCNT(j)]); sum += c; cnt += (c > 0u) ? 1u : 0u; mine = (j == x) ? c : mine; }
        if (sum == G) break;
        __builtin_amdgcn_s_sleep(1);
        if ((++sp & 255u) == 0u) { if (xb_ld(&bar[XB_TMO])) break; if (sp > XB_SPIN_CAP) { atomicAdd(&bar[XB_TMO], 1u); break; } }
    }
    nloc = mine > 0u ? mine : 1u; nx = cnt > 0u ? cnt : 1u;
}

__device__ __forceinline__ void xcd_barrier(const XcdBarrier& b) {
    asm volatile("s_waitcnt vmcnt(0)" ::: "memory");
    __syncthreads();
    if (threadIdx.x == 0) {
        unsigned* bar = b.bar;
        __builtin_amdgcn_s_waitcnt(0);
        unsigned nloc = b.st[0], nx = b.st[1];
        if (nloc == 0u) { xcd_barrier_complete(bar, b.x, nloc, nx); b.st[0] = nloc; b.st[1] = nx; }
        const unsigned old = xb_add(&bar[XB_XSUB(b.x)], 1u);
        const unsigned gen = old / nloc;
        if (old + 1u == (gen + 1u) * nloc) {
            __builtin_amdgcn_fence(__ATOMIC_RELEASE, "agent");
            asm volatile("s_waitcnt vmcnt(0)" ::: "memory");
            const unsigned og = xb_add(&bar[XB_TOP], 1u);
            const unsigned tg = og / nx;
            if (og + 1u == (tg + 1u) * nx) xb_add(&bar[XB_TOPGEN], 1u);
            else XB_SPIN(xb_ld(&bar[XB_TOPGEN]) == tg, bar);
            __builtin_amdgcn_fence(__ATOMIC_ACQUIRE, "agent");
            xb_add(&bar[XB_XGEN(b.x)], 1u);
            asm volatile("s_waitcnt vmcnt(0)" ::: "memory");
        } else {
            XB_SPIN(xb_ld(&bar[XB_XGEN(b.x)]) == gen, bar);
            __builtin_amdgcn_fence(__ATOMIC_ACQUIRE, "agent");
            asm volatile("s_waitcnt vmcnt(0)" ::: "memory");
        }
    }
    __syncthreads();
}

__device__ __forceinline__ unsigned pk_bf16(float lo, float hi) { bf16v2 v = {(__bf16)lo, (__bf16)hi}; return __builtin_bit_cast(unsigned, v); }
__device__ __forceinline__ float bf_lo(unsigned u) { return __uint_as_float(u << 16); }
__device__ __forceinline__ float bf_hi(unsigned u) { return __uint_as_float(u & 0xffff0000u); }
__device__ __forceinline__ float bf_one(u16 u) { return __uint_as_float(((unsigned)u) << 16); }
__device__ __forceinline__ float fast_rcp(float x) { return __builtin_amdgcn_rcpf(x); }
__device__ __forceinline__ float silu_f(float x) { return x * fast_rcp(1.f + __expf(-x)); }
__device__ __forceinline__ float sigmoid_f(float x) { return fast_rcp(1.f + __expf(-x)); }
__device__ __forceinline__ float wave_sum(float v) {
#pragma unroll
    for (int o = 32; o; o >>= 1) v += __shfl_xor(v, o);
    return v;
}
__device__ __forceinline__ u32x4 pk8(const f32x4& a, const f32x4& b) { return (u32x4){pk_bf16(a[0], a[1]), pk_bf16(a[2], a[3]), pk_bf16(b[0], b[1]), pk_bf16(b[2], b[3])}; }
__device__ __forceinline__ int frag_off(int r, int k8, int KB) { return ((r >> 4) * KB + (k8 >> 2)) * 1024 + (((k8 & 3) << 4) + (r & 15)) * 16; }
__device__ __forceinline__ bf16x8 ld_frag(LAS unsigned char* lds, int base, int rt, int ks, int KB, int lane) { return *(const LAS bf16x8*)(lds + base + (rt * KB + ks) * 1024 + lane * 16); }
__device__ __forceinline__ f32x4 mfma16(bf16x8 a, bf16x8 b, f32x4 c) { return __builtin_amdgcn_mfma_f32_16x16x32_bf16(a, b, c, 0, 0, 0); }

#define EPI_ARGS const f32x4 (&acc)[2][2][4][2], const pg8::Unit& u, int wr, int wc, int fr, int fq

struct EpiIn0 {
    static constexpr bool PERM = true, AFTER_DRAIN = false;
    bf16_t* XBC; bf16_t* P4; float* DT;
    __device__ __forceinline__ void operator()(EPI_ARGS) const {
        const int row0 = u.pm * 256 + wr * 64 + fr, cl = wc * 32 + 8 * fq, pn = u.pn;
        if (pn < 8) {
#pragma unroll
            for (int ai = 0; ai < 2; ++ai)
#pragma unroll
                for (int m = 0; m < 4; ++m) { bf16_t* rp = XBC + (size_t)(row0 + ai * 128 + m * 16) * 2048 + pn * 256 + cl;
#pragma unroll
                    for (int bj = 0; bj < 2; ++bj) *(u32x4*)(rp + bj * 128) = pk8(acc[ai][bj][m][0], acc[ai][bj][m][1]); }
        } else if (pn < 16) {
#pragma unroll
            for (int ai = 0; ai < 2; ++ai)
#pragma unroll
                for (int m = 0; m < 4; ++m) { bf16_t* rp = P4 + (size_t)(row0 + ai * 128 + m * 16) * 3072 + (pn - 8) * 128 + cl;
                    *(u32x4*)rp = pk8(acc[ai][0][m][0] * acc[ai][1][m][0], acc[ai][0][m][1] * acc[ai][1][m][1]); }
        } else if (pn < 20) {
#pragma unroll
            for (int ai = 0; ai < 2; ++ai)
#pragma unroll
                for (int m = 0; m < 4; ++m) { bf16_t* rp = P4 + (size_t)(row0 + ai * 128 + m * 16) * 3072 + 1024 + (pn - 16) * 256 + cl;
#pragma unroll
                    for (int bj = 0; bj < 2; ++bj) *(u32x4*)(rp + bj * 128) = pk8(acc[ai][bj][m][0], acc[ai][bj][m][1]); }
        } else if (pn < 24) {
#pragma unroll
            for (int ai = 0; ai < 2; ++ai)
#pragma unroll
                for (int m = 0; m < 4; ++m) { bf16_t* rp = P4 + (size_t)(row0 + ai * 128 + m * 16) * 3072 + 2048 + (pn - 20) * 256 + cl;
#pragma unroll
                    for (int bj = 0; bj < 2; ++bj) { f32x4 a = acc[ai][bj][m][0], b = acc[ai][bj][m][1];
#pragma unroll
                        for (int i = 0; i < 4; ++i) { a[i] = silu_f(a[i]); b[i] = silu_f(b[i]); }
                        *(u32x4*)(rp + bj * 128) = pk8(a, b); } }
        } else if (wc == 0) {
#pragma unroll
            for (int ai = 0; ai < 2; ++ai)
#pragma unroll
                for (int m = 0; m < 4; ++m) { float* rp = DT + (size_t)(row0 + ai * 128 + m * 16) * 32 + 8 * fq;
                    *(f32x4*)rp = acc[ai][0][m][0]; *(f32x4*)(rp + 4) = acc[ai][0][m][1]; }
        }
    }
};
struct EpiRes {
    static constexpr bool PERM = false, AFTER_DRAIN = false;
    const float* srcL; const float* srcC; float* R; const float* gate;
    __device__ __forceinline__ void operator()(EPI_ARGS) const {
        const int row0 = u.pm * 256 + wr * 64 + fr, col0 = u.pn * 256 + wc * 32 + 4 * fq;
        const int j = u.pm < 128 ? (u.pm >> 4) : 8;
        const float* gp = gate + (size_t)j * 6144 + col0;
        f32x4 gv[2][2];
#pragma unroll
        for (int bj = 0; bj < 2; ++bj)
#pragma unroll
            for (int n = 0; n < 2; ++n) gv[bj][n] = *(const f32x4*)(gp + bj * 128 + n * 16);
#pragma unroll
        for (int ai = 0; ai < 2; ++ai)
#pragma unroll
            for (int m = 0; m < 4; ++m) { const int row = row0 + ai * 128 + m * 16;
                const float* sp = (row < ML ? srcL + (size_t)row * 1024 : srcC + (size_t)(row - ML) * 1024) + col0; float* rp = R + (size_t)row * 1024 + col0;
#pragma unroll
                for (int bj = 0; bj < 2; ++bj)
#pragma unroll
                    for (int n = 0; n < 2; ++n) { const f32x4 s = *(const f32x4*)(sp + bj * 128 + n * 16); *(f32x4*)(rp + bj * 128 + n * 16) = s + gv[bj][n] * acc[ai][bj][m][n]; } }
    }
};
struct EpiBf {
    static constexpr bool PERM = true, AFTER_DRAIN = false;
    bf16_t* O; int ldc;
    __device__ __forceinline__ void operator()(EPI_ARGS) const {
        const int row0 = u.pm * 256 + wr * 64 + fr, col0 = u.pn * 256 + wc * 32 + 8 * fq;
#pragma unroll
        for (int ai = 0; ai < 2; ++ai)
#pragma unroll
            for (int m = 0; m < 4; ++m) { bf16_t* rp = O + (size_t)(row0 + ai * 128 + m * 16) * ldc + col0;
#pragma unroll
                for (int bj = 0; bj < 2; ++bj) *(u32x4*)(rp + bj * 128) = pk8(acc[ai][bj][m][0], acc[ai][bj][m][1]); }
    }
};
struct EpiIn1 {
    static constexpr bool PERM = true, AFTER_DRAIN = false;
    bf16_t* PA; bf16_t* SG; const float* LB;
    __device__ __forceinline__ void operator()(EPI_ARGS) const {
        const int row0 = u.pm * 256 + wr * 64 + fr, cl = wc * 32 + 8 * fq, pn = u.pn, grp = pn >> 2, cg = (pn & 3) * 256 + cl;
        if (grp == 4 && u.pm >= 128) return;
#pragma unroll
        for (int bj = 0; bj < 2; ++bj) {
            f32x4 lb0 = {0.f, 0.f, 0.f, 0.f}, lb1 = {0.f, 0.f, 0.f, 0.f};
            if (grp == 1 || grp == 2) { const float* lp = LB + (grp - 1) * 1024 + cg + bj * 128; lb0 = *(const f32x4*)lp; lb1 = *(const f32x4*)(lp + 4); }
#pragma unroll
            for (int ai = 0; ai < 2; ++ai)
#pragma unroll
                for (int m = 0; m < 4; ++m) { const size_t row = (size_t)(row0 + ai * 128 + m * 16);
                    f32x4 a = acc[ai][bj][m][0], b = acc[ai][bj][m][1];
                    if (grp == 0) {
#pragma unroll
                        for (int i = 0; i < 4; ++i) { a[i] = silu_f(a[i]) * 0.08838834764831845f; b[i] = silu_f(b[i]) * 0.08838834764831845f; }
                    } else if (grp == 1 || grp == 2) {
#pragma unroll
                        for (int i = 0; i < 4; ++i) { a[i] = __logf(lb0[i] + (1.f - lb0[i]) * sigmoid_f(a[i])); b[i] = __logf(lb1[i] + (1.f - lb1[i]) * sigmoid_f(b[i])); }
                    } else if (grp == 4) {
#pragma unroll
                        for (int i = 0; i < 4; ++i) { a[i] = silu_f(a[i]); b[i] = silu_f(b[i]); }
                    }
                    bf16_t* rp = (grp == 4) ? SG + row * 1024 + cg + bj * 128 : PA + row * 4096 + grp * 1024 + cg + bj * 128;
                    *(u32x4*)rp = pk8(a, b); }
        }
    }
};

constexpr size_t MiB = (size_t)1 << 20;
constexpr size_t WS_CTL = 0;
constexpr size_t WS_MOD = 65536;
constexpr size_t WS_LB = WS_MOD + (size_t)2 * 9 * 6144 * 4;
constexpr size_t WS_WIN0 = 1 * MiB;
constexpr size_t WS_WOUT0 = WS_WIN0 + (size_t)NIN0 * 1024 * 2;
constexpr size_t WS_WIN1 = WS_WOUT0 + (size_t)1024 * 2048 * 2;
constexpr size_t WS_WOUT1 = WS_WIN1 + (size_t)5120 * 1024 * 2;
constexpr size_t WS_WQ = WS_WOUT1 + (size_t)1024 * 1024 * 2;
constexpr size_t WS_KEYS = WS_WQ + (size_t)2 * 2048 * 1024 * 2;
constexpr size_t WS_WEND = WS_KEYS + (size_t)2 * 8 * 2 * 128 * 128 * 2;
static_assert(WS_WEND <= 39 * MiB, "weights");
constexpr size_t WS_TAB = 39 * MiB;
constexpr size_t WS_Z1 = 103 * MiB;
constexpr size_t WS_Z2 = 239 * MiB;
constexpr size_t WS_R = 375 * MiB;
constexpr size_t WS_END = 511 * MiB;
constexpr size_t WS_XBC = WS_Z1;
constexpr size_t WS_A2 = WS_Z1;
constexpr size_t WS_Q0 = WS_Z1;
constexpr size_t WS_P4 = WS_Z2;
constexpr size_t WS_DT = 443 * MiB;
constexpr size_t WS_YC = 448 * MiB;
constexpr size_t WS_PA = WS_Z1;
constexpr size_t WS_SG = WS_TAB;
constexpr size_t WS_A1 = WS_Z1;
constexpr size_t WS_HF1 = WS_Z1;
constexpr size_t WS_IDX1 = WS_Z1 + 64 * MiB;
constexpr size_t WS_GATE1 = WS_Z1 + 72 * MiB;
constexpr size_t WS_Q1 = WS_Z2;
constexpr size_t DO_H = 0;
constexpr size_t DO_Y1 = 64 * MiB;
constexpr size_t DO_IDX0 = 68 * MiB;
constexpr size_t DO_GATE0 = 77 * MiB;
constexpr int LDS_BYTES = 147456;
constexpr int LDS_MISC = 140 * 1024;

struct Params { const float* in[26]; float* out; unsigned char* ws; int ph_lo, ph_hi; };
struct Frame { LAS unsigned char* lds; int tid, lane, wave, bid, G; };

__device__ __forceinline__ void tr_tile(const Frame& F, const float* __restrict__ src, int ld, int k0, int c0, int nvalid, bf16_t* __restrict__ dst, int K, int n0) {
    LAS float* tile = (LAS float*)F.lds;
    const int kk = F.tid >> 4, n4 = (F.tid & 15) * 4;
#pragma unroll
    for (int i = 0; i < 2; ++i) { const int k = kk + 32 * i; f32x4 v = {0.f, 0.f, 0.f, 0.f};
        if (n4 < nvalid) v = *(const f32x4*)(src + (size_t)(k0 + k) * ld + c0 + n4);
        tile[k * 65 + n4] = v[0]; tile[k * 65 + n4 + 1] = v[1]; tile[k * 65 + n4 + 2] = v[2]; tile[k * 65 + n4 + 3] = v[3]; }
    __syncthreads();
    const int n = F.tid >> 3, k8 = F.tid & 7;
    float f[8];
#pragma unroll
    for (int e = 0; e < 8; ++e) f[e] = tile[(8 * k8 + e) * 65 + n];
    *(u32x4*)(dst + (size_t)(n0 + n) * K + k0 + 8 * k8) = (u32x4){pk_bf16(f[0], f[1]), pk_bf16(f[2], f[3]), pk_bf16(f[4], f[5]), pk_bf16(f[6], f[7])};
    __syncthreads();
}
__device__ __forceinline__ void cvt8(const float* __restrict__ s, bf16_t* __restrict__ d) {
    const f32x4 a = *(const f32x4*)s, b = *(const f32x4*)(s + 4); *(u32x4*)d = pk8(a, b);
}
__device__ __forceinline__ void convert_tables(const Frame& F, const Params& p, int layer) {
    bf16_t* tab = (bf16_t*)(p.ws + WS_TAB);
    for (size_t i = (size_t)F.bid * 512 + F.tid; i < (size_t)2 * 2097152; i += (size_t)F.G * 512) {
        const int t = (int)(i >> 21); const size_t j = i & 2097151;
        cvt8((t ? p.in[25] : p.in[24]) + (size_t)layer * 16384 * 1024 + 8 * j, tab + (size_t)t * 16384 * 1024 + 8 * j);
    }
}
__device__ __forceinline__ void p0_prologue(const Frame& F, const Params& p) {
    unsigned char* ws = p.ws;
    for (int u = F.bid; u < 192; u += F.G) {
        const int layer = u / 96, cg = u % 96;
        LAS float* sc = (LAS float*)F.lds; LAS float* red = sc + 9 * 1024;
        for (int e = F.tid; e < 9216; e += 512) { const int j = e >> 10, k = e & 1023; const float cv = j < 8 ? p.in[1][j * 1024 + k] : p.in[3][k]; sc[e] = silu_f(cv); }
        __syncthreads();
        const int col = F.tid & 63, ks = F.tid >> 6;
        float acc[9];
#pragma unroll
        for (int j = 0; j < 9; ++j) acc[j] = 0.f;
        const float* wp = p.in[4] + (size_t)layer * 1024 * 6144 + (size_t)(ks * 128) * 6144 + cg * 64 + col;
        for (int k = 0; k < 128; ++k) { const float w = wp[(size_t)k * 6144];
#pragma unroll
            for (int j = 0; j < 9; ++j) acc[j] += sc[j * 1024 + ks * 128 + k] * w; }
#pragma unroll
        for (int j = 0; j < 9; ++j) red[(ks * 9 + j) * 64 + col] = acc[j];
        __syncthreads();
        for (int e = F.tid; e < 576; e += 512) { const int j = e >> 6, c = e & 63; float s = 0.f;
#pragma unroll
            for (int q = 0; q < 8; ++q) s += red[(q * 9 + j) * 64 + c];
            ((float*)(ws + WS_MOD))[(size_t)(layer * 9 + j) * 6144 + cg * 64 + c] = s + p.in[5][layer * 6144 + cg * 64 + c]; }
        __syncthreads();
    }
    for (int e = F.bid * 512 + F.tid; e < 2048; e += F.G * 512) { const float l0 = p.in[20][e], l1 = p.in[20][2048 + e]; ((float*)(ws + WS_LB))[e] = fast_rcp(1.f + __expf(l0 - l1)); }
    for (int u = F.bid; u < 4672; u += F.G) {
        const float* src; int ld, K, nt, kt, c0, nv = 64; bf16_t* dst;
        if (u < 1600) { nt = u >> 4; kt = u & 15; src = p.in[9]; ld = EVEN_IN; K = 1024; dst = (bf16_t*)(ws + WS_WIN0);
            if (nt < 32) c0 = 4096 + 64 * nt;
            else if (nt < 64) { const int uu = nt - 32, j = uu >> 2, q = uu & 3; c0 = q < 2 ? 128 * j + 64 * q : 2048 + 128 * j + 64 * (q - 2); }
            else if (nt < 80) c0 = 1024 + 64 * (nt - 64);
            else if (nt < 96) c0 = 3072 + 64 * (nt - 80);
            else if (nt == 96) { c0 = 6144; nv = 32; }
            else { c0 = 0; nv = 0; } }
        else if (u < 2112) { const int v = u - 1600; nt = v >> 5; kt = v & 31; src = p.in[10]; ld = 1024; K = 2048; dst = (bf16_t*)(ws + WS_WOUT0); c0 = 64 * nt; }
        else if (u < 3392) { const int v = u - 2112; nt = v >> 4; kt = v & 15; src = p.in[18]; ld = ODD_IN; K = 1024; dst = (bf16_t*)(ws + WS_WIN1); c0 = 64 * nt; }
        else if (u < 3648) { const int v = u - 3392; nt = v >> 4; kt = v & 15; src = p.in[19]; ld = 1024; K = 1024; dst = (bf16_t*)(ws + WS_WOUT1); c0 = 64 * nt; }
        else { const int v = u - 3648, layer = v >> 9, w = v & 511; nt = w >> 4; kt = w & 15; src = p.in[22] + (size_t)layer * 1024 * 2048; ld = 2048; K = 1024; dst = (bf16_t*)(ws + WS_WQ) + (size_t)layer * 2048 * 1024; c0 = 64 * nt; }
        tr_tile(F, src, ld, kt * 64, c0, nv, dst, K, nt * 64);
    }
    for (int i = F.bid * 512 + F.tid; i < 65536; i += F.G * 512) cvt8(p.in[23] + (size_t)8 * i, (bf16_t*)(ws + WS_KEYS) + (size_t)8 * i);
    convert_tables(F, p, 0);
}

__device__ __forceinline__ void phase_norm(const Frame& F, const float* __restrict__ srcL, const float* __restrict__ srcC, int M, const float* __restrict__ w,
                                           const float* __restrict__ mod, int shift_off, int scale_off, bf16_t* __restrict__ H) {
    for (int row = F.bid * 8 + F.wave; row < M; row += F.G * 8) {
        const float* sp = row < ML ? srcL + (size_t)row * 1024 : srcC + (size_t)(row - ML) * 1024;
        const int j = row < ML ? (row >> 12) : 8;
        f32x4 x[4]; float ss = 0.f;
#pragma unroll
        for (int i = 0; i < 4; ++i) { x[i] = *(const f32x4*)(sp + 256 * i + 4 * F.lane); ss += x[i][0] * x[i][0] + x[i][1] * x[i][1] + x[i][2] * x[i][2] + x[i][3] * x[i][3]; }
        ss = wave_sum(ss);
        const float rs = rsqrtf(ss * (1.f / 1024.f) + NORM_EPS);
        const float* mp = mod + (size_t)j * 6144;
#pragma unroll
        for (int i = 0; i < 4; ++i) { const int col = 256 * i + 4 * F.lane;
            const f32x4 wv = *(const f32x4*)(w + col), sc = *(const f32x4*)(mp + scale_off + col), sh = *(const f32x4*)(mp + shift_off + col);
            f32x4 h;
#pragma unroll
            for (int e = 0; e < 4; ++e) h[e] = x[i][e] * rs * wv[e] * (1.f + sc[e]) + sh[e];
            *(u32x2*)(H + (size_t)row * 1024 + col) = (u32x2){pk_bf16(h[0], h[1]), pk_bf16(h[2], h[3])}; }
    }
}

__device__ __forceinline__ void phase_conv(const Frame& F, const Params& p) {
    bf16_t* X = (bf16_t*)(p.ws + WS_XBC);
    const float* cw = p.in[12]; const float* cb = p.in[13];
    for (int u = F.bid; u < 8704; u += F.G) {
        int row0, nrows, col0, lcv;
        if (u < 8192) { row0 = (u >> 4) * 64; nrows = 64; col0 = (u & 15) * 128; lcv = 4; }
        else { const int v = u - 8192; row0 = ML + (v >> 6) * 256; nrows = 256; col0 = (v & 63) * 32; lcv = 2; }
        const int vc = F.tid & ((1 << lcv) - 1), ra = 2 * (F.tid >> lcv), col = col0 + 8 * vc;
        bf16_t* base = X + (size_t)row0 * 2048 + col;
        u32x4 L[4];
#pragma unroll
        for (int q = 0; q < 4; ++q) { const int lr = ra - 1 + q; L[q] = (u32x4){0u, 0u, 0u, 0u}; if (lr >= 0 && lr < nrows) L[q] = *(const u32x4*)(base + (size_t)lr * 2048); }
        float oa[8], ob[8];
#pragma unroll
        for (int hh = 0; hh < 2; ++hh) {
            const f32x4 w0 = *(const f32x4*)(cw + col + 4 * hh), w1 = *(const f32x4*)(cw + 2048 + col + 4 * hh), w2 = *(const f32x4*)(cw + 4096 + col + 4 * hh), bb = *(const f32x4*)(cb + col + 4 * hh);
#pragma unroll
            for (int e = 0; e < 4; ++e) { const int dw = 2 * hh + (e >> 1);
                const float xm = (e & 1) ? bf_hi(L[0][dw]) : bf_lo(L[0][dw]), x0 = (e & 1) ? bf_hi(L[1][dw]) : bf_lo(L[1][dw]);
                const float x1 = (e & 1) ? bf_hi(L[2][dw]) : bf_lo(L[2][dw]), x2 = (e & 1) ? bf_hi(L[3][dw]) : bf_lo(L[3][dw]);
                oa[4 * hh + e] = silu_f(bb[e] + w0[e] * xm + w1[e] * x0 + w2[e] * x1);
                ob[4 * hh + e] = silu_f(bb[e] + w0[e] * x0 + w1[e] * x1 + w2[e] * x2); }
        }
        const u32x4 va = {pk_bf16(oa[0], oa[1]), pk_bf16(oa[2], oa[3]), pk_bf16(oa[4], oa[5]), pk_bf16(oa[6], oa[7])};
        const u32x4 vb = {pk_bf16(ob[0], ob[1]), pk_bf16(ob[2], ob[3]), pk_bf16(ob[4], ob[5]), pk_bf16(ob[6], ob[7])};
        __syncthreads();
        *(u32x4*)(base + (size_t)ra * 2048) = va; *(u32x4*)(base + (size_t)(ra + 1) * 2048) = vb;
    }
}

constexpr int SS_CM = 0, SS_BM = 16384, SS_BMT = 32768, SS_XDT = 49152, SS_XET = 57344, SS_XR = 65536, SS_GM = 73728, SS_ST = 81920, SS_YST = 98304, SS_LA = 106496;
__device__ __forceinline__ int chunk_row0(int q, int b, int d) { if (q < 4) { const int c = d ? 3 - q : q; return ML + b * 256 + 64 * c; } const int c = d ? 67 - q : q - 4; return b * 4096 + 64 * c; }
__device__ __forceinline__ float softplus_f(float x) { return fmaxf(x, 0.f) + __logf(1.f + __expf(-fabsf(x))); }
__device__ __forceinline__ u16 dw_elem(const u32x4& v, int e) { return (u16)((e & 1) ? (v[e >> 1] >> 16) : (v[e >> 1] & 0xffffu)); }

__device__ __forceinline__ void phase_ssd(const Frame& F, const Params& p) {
    LAS unsigned char* lds = F.lds;
    const bf16_t* XBC = (const bf16_t*)(p.ws + WS_XBC); const float* DT = (const float*)(p.ws + WS_DT);
    const int tid = F.tid, lane = F.lane, wave = F.wave, fr = lane & 15, fq = lane >> 4;
    const int cs0 = tid >> 4, ck8 = tid & 15, xs = tid >> 3, xp8 = tid & 7;
    for (int u = F.bid; u < 256; u += F.G) {
        const int b = u >> 5, h = (u >> 1) & 15, d = u & 1, g = h >> 2;
        const float a = -__expf(p.in[15][d * 16 + h]), bias = p.in[14][d * 16 + h], dsk = p.in[16][h];
        bf16_t* YL = (bf16_t*)((unsigned char*)p.out + (d ? DO_Y1 : 0)); bf16_t* YC = (bf16_t*)(p.ws + WS_YC) + (size_t)d * 2048 * 1024;
        for (int i = tid; i < 1024; i += 512) *(LAS u32x4*)(lds + SS_ST + i * 16) = (u32x4){0u, 0u, 0u, 0u};
        f32x4 S[4];
#pragma unroll
        for (int i = 0; i < 4; ++i) S[i] = (f32x4){0.f, 0.f, 0.f, 0.f};
        u32x4 cm[2], bm[2], xv; float dtr;
        { const int r0 = chunk_row0(0, b, d); const bf16_t* rp = XBC + (size_t)r0 * 2048;
#pragma unroll
          for (int i = 0; i < 2; ++i) { cm[i] = *(const u32x4*)(rp + (size_t)(cs0 + 32 * i) * 2048 + 1536 + g * 128 + ck8 * 8); bm[i] = *(const u32x4*)(rp + (size_t)(cs0 + 32 * i) * 2048 + 1024 + g * 128 + ck8 * 8); }
          xv = *(const u32x4*)(rp + (size_t)xs * 2048 + h * 64 + xp8 * 8); dtr = DT[(size_t)(r0 + lane) * 32 + d * 16 + h]; }
        for (int q = 0; q < 68; ++q) {
            const int r0 = chunk_row0(q, b, d);
            const float dt = softplus_f(dtr + bias);
            float la = dt * a;
            if (d == 0) {
#pragma unroll
                for (int o = 1; o < 64; o <<= 1) { const float t = __shfl_up(la, o); if (lane >= o) la += t; }
            } else {
#pragma unroll
                for (int o = 1; o < 64; o <<= 1) { const float t = __shfl_down(la, o); if (lane + o < 64) la += t; }
            }
            const float la_end = __shfl(la, d ? 0 : 63);
            const float ee = __expf(la_end - la) * dt;
            if (wave == 0) *(LAS float*)(lds + SS_LA + lane * 4) = la;
#pragma unroll
            for (int i = 0; i < 2; ++i) { const int s = cs0 + 32 * i;
                *(LAS u32x4*)(lds + SS_CM + frag_off(s, ck8, 4)) = cm[i]; *(LAS u32x4*)(lds + SS_BM + frag_off(s, ck8, 4)) = bm[i];
#pragma unroll
                for (int e = 0; e < 8; ++e) *(LAS u16*)(lds + SS_BMT + frag_off(ck8 * 8 + e, s >> 3, 2) + (s & 7) * 2) = dw_elem(bm[i], e); }
            { const float dts = __shfl(dt, xs), ees = __shfl(ee, xs);
              *(LAS u32x4*)(lds + SS_XR + xs * 128 + xp8 * 16) = xv;
#pragma unroll
              for (int e = 0; e < 8; ++e) { const float x = bf_one(dw_elem(xv, e)); const unsigned pkd = pk_bf16(x * dts, x * ees);
                  const int off = frag_off(xp8 * 8 + e, xs >> 3, 2) + (xs & 7) * 2;
                  *(LAS u16*)(lds + SS_XDT + off) = (u16)(pkd & 0xffffu); *(LAS u16*)(lds + SS_XET + off) = (u16)(pkd >> 16); } }
            if (q + 1 < 68) { const int r1 = chunk_row0(q + 1, b, d); const bf16_t* rp = XBC + (size_t)r1 * 2048;
#pragma unroll
                for (int i = 0; i < 2; ++i) { cm[i] = *(const u32x4*)(rp + (size_t)(cs0 + 32 * i) * 2048 + 1536 + g * 128 + ck8 * 8); bm[i] = *(const u32x4*)(rp + (size_t)(cs0 + 32 * i) * 2048 + 1024 + g * 128 + ck8 * 8); }
                xv = *(const u32x4*)(rp + (size_t)xs * 2048 + h * 64 + xp8 * 8); dtr = DT[(size_t)(r1 + lane) * 32 + d * 16 + h]; }
            __syncthreads();
            { const int si = wave >> 1, tt0 = (wave & 1) * 2;
              bf16x8 af[4];
#pragma unroll
              for (int ks = 0; ks < 4; ++ks) af[ks] = ld_frag(lds, SS_BM, si, ks, 4, lane);
#pragma unroll
              for (int ts = 0; ts < 2; ++ts) { const int tt = tt0 + ts; f32x4 acc = {0.f, 0.f, 0.f, 0.f};
#pragma unroll
                  for (int ks = 0; ks < 4; ++ks) acc = mfma16(af[ks], ld_frag(lds, SS_CM, tt, ks, 4, lane), acc);
                  const int t = 16 * tt + fr, s0 = 16 * si + 4 * fq; const float lat = *(LAS float*)(lds + SS_LA + t * 4);
                  const f32x4 las = *(LAS f32x4*)(lds + SS_LA + s0 * 4); float v[4];
#pragma unroll
                  for (int j = 0; j < 4; ++j) { const int s = s0 + j; const bool ok = d ? (s >= t) : (s <= t); v[j] = ok ? acc[j] * __expf(lat - las[j]) : 0.f; }
                  *(LAS u32x2*)(lds + SS_GM + frag_off(t, s0 >> 3, 2) + (s0 & 7) * 2) = (u32x2){pk_bf16(v[0], v[1]), pk_bf16(v[2], v[3])}; } }
            const int ytt = wave >> 1, ypt0 = (wave & 1) * 2;
            f32x4 y2[2] = {{0.f, 0.f, 0.f, 0.f}, {0.f, 0.f, 0.f, 0.f}};
#pragma unroll
            for (int ks = 0; ks < 4; ++ks) { const bf16x8 bf = ld_frag(lds, SS_CM, ytt, ks, 4, lane);
#pragma unroll
                for (int ps = 0; ps < 2; ++ps) y2[ps] = mfma16(ld_frag(lds, SS_ST, ypt0 + ps, ks, 4, lane), bf, y2[ps]); }
            { const float dec = __expf(la_end);
#pragma unroll
              for (int pt = 0; pt < 4; ++pt) S[pt] *= dec;
#pragma unroll
              for (int ks = 0; ks < 2; ++ks) { const bf16x8 af = ld_frag(lds, SS_BMT, wave, ks, 2, lane);
#pragma unroll
                  for (int pt = 0; pt < 4; ++pt) S[pt] = mfma16(af, ld_frag(lds, SS_XET, pt, ks, 2, lane), S[pt]); } }
            __syncthreads();
            { f32x4 y1[2] = {{0.f, 0.f, 0.f, 0.f}, {0.f, 0.f, 0.f, 0.f}};
#pragma unroll
              for (int ks = 0; ks < 2; ++ks) { const bf16x8 bf = ld_frag(lds, SS_GM, ytt, ks, 2, lane);
#pragma unroll
                  for (int ps = 0; ps < 2; ++ps) y1[ps] = mfma16(ld_frag(lds, SS_XDT, ypt0 + ps, ks, 2, lane), bf, y1[ps]); }
              const int t = 16 * ytt + fr; const float sc = __expf(*(LAS float*)(lds + SS_LA + t * 4));
#pragma unroll
              for (int ps = 0; ps < 2; ++ps) { const int p0 = 16 * (ypt0 + ps) + 4 * fq; float y[4];
#pragma unroll
                  for (int j = 0; j < 4; ++j) y[j] = y1[ps][j] + sc * y2[ps][j];
                  if (d == 0) { const u32x2 xr = *(LAS u32x2*)(lds + SS_XR + t * 128 + p0 * 2); y[0] += dsk * bf_lo(xr[0]); y[1] += dsk * bf_hi(xr[0]); y[2] += dsk * bf_lo(xr[1]); y[3] += dsk * bf_hi(xr[1]); }
                  *(LAS u32x2*)(lds + SS_YST + t * 128 + p0 * 2) = (u32x2){pk_bf16(y[0], y[1]), pk_bf16(y[2], y[3])}; }
              const int n0 = 16 * wave + 4 * fq;
#pragma unroll
              for (int pt = 0; pt < 4; ++pt) *(LAS u32x2*)(lds + SS_ST + frag_off(16 * pt + fr, n0 >> 3, 4) + (n0 & 7) * 2) = (u32x2){pk_bf16(S[pt][0], S[pt][1]), pk_bf16(S[pt][2], S[pt][3])}; }
            __syncthreads();
            { const int t = tid >> 3, pc = tid & 7; const u32x4 v = *(LAS u32x4*)(lds + SS_YST + t * 128 + pc * 16);
              bf16_t* yp = (r0 >= ML) ? YC + (size_t)(r0 - ML + t) * 1024 : YL + (size_t)(r0 + t) * 1024;
              *(u32x4*)(yp + h * 64 + pc * 8) = v; }
        }
        __syncthreads();
    }
}

__device__ __forceinline__ void phase_finish0(const Frame& F, const Params& p) {
    const bf16_t* P4 = (const bf16_t*)(p.ws + WS_P4); bf16_t* A2 = (bf16_t*)(p.ws + WS_A2);
    const bf16_t* YL0 = (const bf16_t*)p.out; const bf16_t* YL1 = (const bf16_t*)((const unsigned char*)p.out + DO_Y1);
    const bf16_t* YC0 = (const bf16_t*)(p.ws + WS_YC); const bf16_t* YC1 = YC0 + (size_t)2048 * 1024;
    const float* cw = p.in[11]; const float* nw = p.in[17];
    const int c0 = F.lane * 16;
    for (int row = F.bid * 8 + F.wave; row < MA; row += F.G * 8) {
        bool hp, hn;
        if (row < ML) { const int lr = row & 63; hp = lr > 0; hn = lr < 63; } else { const int lr = (row - ML) & 255; hp = lr > 0; hn = lr < 255; }
        const bf16_t* pr = P4 + (size_t)row * 3072 + c0;
        u32x4 pc[2], pp[2], pn[2], sb[2], sz[2], y0[2], y1[2];
        const bf16_t* y0p = row < ML ? YL0 + (size_t)row * 1024 + c0 : YC0 + (size_t)(row - ML) * 1024 + c0;
        const bf16_t* y1p = row < ML ? YL1 + (size_t)row * 1024 + c0 : YC1 + (size_t)(row - ML) * 1024 + c0;
#pragma unroll
        for (int i = 0; i < 2; ++i) { pc[i] = *(const u32x4*)(pr + 8 * i); sb[i] = *(const u32x4*)(pr + 1024 + 8 * i); sz[i] = *(const u32x4*)(pr + 2048 + 8 * i);
            pp[i] = (u32x4){0u, 0u, 0u, 0u}; pn[i] = (u32x4){0u, 0u, 0u, 0u};
            if (hp) pp[i] = *(const u32x4*)(pr - 3072 + 8 * i);
            if (hn) pn[i] = *(const u32x4*)(pr + 3072 + 8 * i);
            y0[i] = *(const u32x4*)(y0p + 8 * i); y1[i] = *(const u32x4*)(y1p + 8 * i); }
        float ya[16], yb[16]; float ss = 0.f;
#pragma unroll
        for (int i = 0; i < 2; ++i)
#pragma unroll
            for (int q = 0; q < 2; ++q) { const int cc = c0 + 8 * i + 4 * q;
                const f32x4 w0 = *(const f32x4*)(cw + cc), w1 = *(const f32x4*)(cw + 1024 + cc), w2 = *(const f32x4*)(cw + 2048 + cc);
#pragma unroll
                for (int e = 0; e < 4; ++e) { const int dw = 2 * q + (e >> 1), o = 8 * i + 4 * q + e;
                    const float xp = (e & 1) ? bf_hi(pp[i][dw]) : bf_lo(pp[i][dw]), xc = (e & 1) ? bf_hi(pc[i][dw]) : bf_lo(pc[i][dw]), xn = (e & 1) ? bf_hi(pn[i][dw]) : bf_lo(pn[i][dw]);
                    const float bv = (e & 1) ? bf_hi(sb[i][dw]) : bf_lo(sb[i][dw]), zv = (e & 1) ? bf_hi(sz[i][dw]) : bf_lo(sz[i][dw]);
                    const float ya0 = (e & 1) ? bf_hi(y0[i][dw]) : bf_lo(y0[i][dw]), ya1 = (e & 1) ? bf_hi(y1[i][dw]) : bf_lo(y1[i][dw]);
                    ya[o] = bv * (w0[e] * xp + w1[e] * xc + w2[e] * xn);
                    const float v = (ya0 + ya1) * zv; yb[o] = v; ss += v * v; } }
        ss += __shfl_xor(ss, 1); ss += __shfl_xor(ss, 2); ss += __shfl_xor(ss, 4); ss += __shfl_xor(ss, 8);
        const float rs = rsqrtf(ss * (1.f / 256.f) + NORM_EPS);
        bf16_t* ap = A2 + (size_t)row * 2048 + c0;
#pragma unroll
        for (int i = 0; i < 2; ++i) {
            const f32x4 g0 = *(const f32x4*)(nw + c0 + 8 * i), g1 = *(const f32x4*)(nw + c0 + 8 * i + 4);
            *(u32x4*)(ap + 8 * i) = (u32x4){pk_bf16(ya[8 * i], ya[8 * i + 1]), pk_bf16(ya[8 * i + 2], ya[8 * i + 3]), pk_bf16(ya[8 * i + 4], ya[8 * i + 5]), pk_bf16(ya[8 * i + 6], ya[8 * i + 7])};
            *(u32x4*)(ap + 1024 + 8 * i) = (u32x4){pk_bf16(yb[8 * i] * rs * g0[0], yb[8 * i + 1] * rs * g0[1]), pk_bf16(yb[8 * i + 2] * rs * g0[2], yb[8 * i + 3] * rs * g0[3]),
                                                   pk_bf16(yb[8 * i + 4] * rs * g1[0], yb[8 * i + 5] * rs * g1[1]), pk_bf16(yb[8 * i + 6] * rs * g1[2], yb[8 * i + 7] * rs * g1[3])}; }
    }
}

__device__ __forceinline__ int enc_key(float s) { const int b = __float_as_int(s); return b ^ ((b >> 31) & 0x7fffffff); }
__device__ __forceinline__ float dec_key(int k) { return __int_as_float(k ^ ((k >> 31) & 0x7fffffff)); }
__device__ __forceinline__ int med3i(int a, int b, int c) { return max(min(a, b), min(max(a, b), c)); }
#define TK_INSERT(L, v) do { _Pragma("unroll") for (int _i = 15; _i > 0; --_i) L[_i] = med3i(L[_i - 1], L[_i], (v)); L[0] = max(L[0], (v)); } while (0)
__device__ __forceinline__ void tk_merge(int (&L)[16], int xr) {
    int P[16];
#pragma unroll
    for (int i = 0; i < 16; ++i) P[i] = __shfl_xor(L[i], xr);
#pragma unroll
    for (int i = 0; i < 16; ++i) L[i] = max(L[i], P[15 - i]);
#pragma unroll
    for (int st = 8; st > 0; st >>= 1)
#pragma unroll
        for (int i = 0; i < 16; ++i) if ((i & st) == 0) { const int a = L[i], b = L[i + st]; L[i] = max(a, b); L[i + st] = min(a, b); }
}
constexpr int TK_Q = 0, TK_K = 65536;
__device__ __forceinline__ void topk_half(LAS unsigned char* lds, int a, int wave, int lane, int (&L)[16]) {
    const int fq = lane >> 4;
#pragma unroll
    for (int i = 0; i < 16; ++i) L[i] = (int)0x80000000;
    bf16x8 bq[4];
#pragma unroll
    for (int ks = 0; ks < 4; ++ks) bq[ks] = ld_frag(lds, TK_Q, wave, a * 4 + ks, 8, lane);
#pragma unroll
    for (int n = 0; n < 8; ++n) { f32x4 acc = {0.f, 0.f, 0.f, 0.f};
#pragma unroll
        for (int ks = 0; ks < 4; ++ks) acc = mfma16(ld_frag(lds, TK_K, a * 8 + n, ks, 4, lane), bq[ks], acc);
#pragma unroll
        for (int j = 0; j < 4; ++j) { const int key = (enc_key(acc[j]) & ~127) | (16 * n + 4 * fq + j); TK_INSERT(L, key); } }
    tk_merge(L, 16); tk_merge(L, 32);
}
__device__ __forceinline__ unsigned tk_lookup(const unsigned (&P)[4], int i) {
    const int q = i >> 2; const unsigned dwv = q == 0 ? P[0] : (q == 1 ? P[1] : (q == 2 ? P[2] : P[3]));
    return (dwv >> ((i & 3) * 8)) & 127u;
}
__device__ __forceinline__ void phase_topk(const Frame& F, const Params& p, int layer, const bf16_t* __restrict__ Q, int M, u16* __restrict__ IDX, float* __restrict__ GATE) {
    LAS unsigned char* lds = F.lds;
    const bf16_t* KEYS = (const bf16_t*)(p.ws + WS_KEYS) + (size_t)layer * 8 * 2 * 128 * 128;
    const int tid = F.tid, lane = F.lane, wave = F.wave, fr = lane & 15, fq = lane >> 4;
    const int nunits = (M >> 7) * 8;
    for (int u = F.bid; u < nunits; u += F.G) {
        const int head = u & 7, row0 = (u >> 3) * 128;
#pragma unroll
        for (int i = 0; i < 8; ++i) { const int o = tid + 512 * i, r = o >> 5, k8 = o & 31;
            *(LAS u32x4*)(lds + TK_Q + frag_off(r, k8, 8)) = *(const u32x4*)(Q + (size_t)(row0 + r) * 2048 + head * 256 + k8 * 8); }
#pragma unroll
        for (int i = 0; i < 8; ++i) { const int o = tid + 512 * i, r = o >> 4, k8 = o & 15;
            *(LAS u32x4*)(lds + TK_K + frag_off(r, k8, 4)) = *(const u32x4*)(KEYS + (size_t)(head * 256 + r) * 128 + k8 * 8); }
        __syncthreads();
        int L0[16], L1[16];
        topk_half(lds, 0, wave, lane, L0);
        topk_half(lds, 1, wave, lane, L1);
        float f0[16], f1[16];
#pragma unroll
        for (int i = 0; i < 16; ++i) { f0[i] = dec_key(L0[i] & ~127); f1[i] = dec_key(L1[i] & ~127); }
        int C[16];
#pragma unroll
        for (int i = 0; i < 16; ++i) C[i] = (int)0x80000000;
#pragma unroll
        for (int i = 0; i < 16; ++i)
#pragma unroll
            for (int j = 0; j < 16; ++j) if ((i + 1) * (j + 1) <= 16) { const int key = (enc_key(f0[i] + f1[j]) & ~255) | (i * 16 + j); TK_INSERT(C, key); }
        unsigned P0[4], P1[4];
#pragma unroll
        for (int q = 0; q < 4; ++q) { P0[q] = (unsigned)(L0[4 * q] & 127) | ((unsigned)(L0[4 * q + 1] & 127) << 8) | ((unsigned)(L0[4 * q + 2] & 127) << 16) | ((unsigned)(L0[4 * q + 3] & 127) << 24);
                                      P1[q] = (unsigned)(L1[4 * q] & 127) | ((unsigned)(L1[4 * q + 1] & 127) << 8) | ((unsigned)(L1[4 * q + 2] & 127) << 16) | ((unsigned)(L1[4 * q + 3] & 127) << 24); }
        const float mx = dec_key(C[0] & ~255);
        float ev[16]; float sum = 0.f; unsigned eidx[16];
#pragma unroll
        for (int k = 0; k < 16; ++k) { ev[k] = __expf(dec_key(C[k] & ~255) - mx); sum += ev[k];
            const int pos = C[k] & 255; eidx[k] = tk_lookup(P0, pos >> 4) * 128u + tk_lookup(P1, pos & 15); }
        const float inv = 1.f / sum;
        if (fq == 0) { const size_t o = (size_t)(row0 + 16 * wave + fr) * 128 + head * 16;
#pragma unroll
            for (int q = 0; q < 2; ++q) *(u32x4*)(IDX + o + 8 * q) = (u32x4){eidx[8 * q] | (eidx[8 * q + 1] << 16), eidx[8 * q + 2] | (eidx[8 * q + 3] << 16), eidx[8 * q + 4] | (eidx[8 * q + 5] << 16), eidx[8 * q + 6] | (eidx[8 * q + 7] << 16)};
#pragma unroll
            for (int q = 0; q < 4; ++q) *(f32x4*)(GATE + o + 4 * q) = (f32x4){ev[4 * q] * inv, ev[4 * q + 1] * inv, ev[4 * q + 2] * inv, ev[4 * q + 3] * inv}; }
        __syncthreads();
    }
}

__device__ __forceinline__ float dot2bf(unsigned a, unsigned b, float c) { return __builtin_amdgcn_fdot2_f32_bf16(__builtin_bit_cast(bf16v2, a), __builtin_bit_cast(bf16v2, b), c, false); }
template <bool FINAL>
__device__ __forceinline__ void phase_gather(const Frame& F, const Params& p, int layer, const bf16_t* __restrict__ HF, const u16* __restrict__ IDX, const float* __restrict__ GATE, int M, float* R) {
    const bf16_t* U = (const bf16_t*)(p.ws + WS_TAB); const bf16_t* V = U + (size_t)16384 * 1024;
    const float* mod = (const float*)(p.ws + WS_MOD) + (size_t)layer * 9 * 6144 + 5 * 1024;
    const int lane = F.lane;
    for (int row = F.bid * 8 + F.wave; row < M; row += F.G * 8) {
        const int jb = row < ML ? (row >> 12) : 8;
        const bf16_t* hp = HF + (size_t)row * 1024 + 8 * lane;
        const u32x4 h0 = *(const u32x4*)hp, h1 = *(const u32x4*)(hp + 512);
        const int id0 = IDX[(size_t)row * 128 + lane], id1 = IDX[(size_t)row * 128 + 64 + lane];
        const float g0 = GATE[(size_t)row * 128 + lane], g1 = GATE[(size_t)row * 128 + 64 + lane];
        float out[16];
#pragma unroll
        for (int i = 0; i < 16; ++i) out[i] = 0.f;
        for (int bt = 0; bt < 16; ++bt) {
            const int idv = bt < 8 ? id0 : id1; const float gv = bt < 8 ? g0 : g1; const int lb = (bt & 7) * 8;
            u32x4 uu[8][2], vv[8][2];
#pragma unroll
            for (int e = 0; e < 8; ++e) { const int eid = __builtin_amdgcn_readlane(idv, lb + e);
                const bf16_t* up = U + (size_t)eid * 1024 + 8 * lane; const bf16_t* vp = V + (size_t)eid * 1024 + 8 * lane;
                uu[e][0] = *(const u32x4*)up; uu[e][1] = *(const u32x4*)(up + 512); vv[e][0] = *(const u32x4*)vp; vv[e][1] = *(const u32x4*)(vp + 512); }
            float dts[8];
#pragma unroll
            for (int e = 0; e < 8; ++e) { float acc = 0.f;
#pragma unroll
                for (int i = 0; i < 4; ++i) { acc = dot2bf(uu[e][0][i], h0[i], acc); acc = dot2bf(uu[e][1][i], h1[i], acc); }
                dts[e] = acc; }
            float r4[4], r2[2], r1;
            { const bool hi = (lane & 1) != 0;
#pragma unroll
              for (int i = 0; i < 4; ++i) { const float send = hi ? dts[i] : dts[4 + i], keep = hi ? dts[4 + i] : dts[i]; r4[i] = keep + __shfl_xor(send, 1); } }
            { const bool hi = (lane & 2) != 0;
#pragma unroll
              for (int i = 0; i < 2; ++i) { const float send = hi ? r4[i] : r4[2 + i], keep = hi ? r4[2 + i] : r4[i]; r2[i] = keep + __shfl_xor(send, 2); } }
            { const bool hi = (lane & 4) != 0; const float send = hi ? r2[0] : r2[1], keep = hi ? r2[1] : r2[0]; r1 = keep + __shfl_xor(send, 4); }
            r1 += __shfl_xor(r1, 8); r1 += __shfl_xor(r1, 16); r1 += __shfl_xor(r1, 32);
            const int el = ((lane & 1) << 2) | (lane & 2) | ((lane >> 2) & 1);
            const float gl = __shfl(gv, lb + el);
            const float act = gl * 0.5f * r1 * (1.f + erff(r1 * 0.70710678118654752f));
#pragma unroll
            for (int e = 0; e < 8; ++e) { const int le = ((e >> 2) & 1) | (e & 2) | ((e & 1) << 2);
                const float ae = __int_as_float(__builtin_amdgcn_readlane(__float_as_int(act), le));
#pragma unroll
                for (int i = 0; i < 4; ++i) { out[2 * i] += ae * bf_lo(vv[e][0][i]); out[2 * i + 1] += ae * bf_hi(vv[e][0][i]); out[8 + 2 * i] += ae * bf_lo(vv[e][1][i]); out[8 + 2 * i + 1] += ae * bf_hi(vv[e][1][i]); } }
        }
        const float* gp = mod + (size_t)jb * 6144;
        float* rp = R + (size_t)row * 1024;
        f32x4 x[4];
#pragma unroll
        for (int q = 0; q < 4; ++q) { const int col = (q >> 1) * 512 + 8 * lane + 4 * (q & 1); const f32x4 g5 = *(const f32x4*)(gp + col), r = *(const f32x4*)(rp + col);
#pragma unroll
            for (int e = 0; e < 4; ++e) x[q][e] = r[e] + g5[e] * out[4 * q + e]; }
        if (!FINAL) {
#pragma unroll
            for (int q = 0; q < 4; ++q) *(f32x4*)(rp + (q >> 1) * 512 + 8 * lane + 4 * (q & 1)) = x[q];
        } else {
            float ss = 0.f;
#pragma unroll
            for (int q = 0; q < 4; ++q) ss += x[q][0] * x[q][0] + x[q][1] * x[q][1] + x[q][2] * x[q][2] + x[q][3] * x[q][3];
            ss = wave_sum(ss);
            const float rs = rsqrtf(ss * (1.f / 1024.f) + NORM_EPS);
#pragma unroll
            for (int q = 0; q < 4; ++q) { const int col = (q >> 1) * 512 + 8 * lane + 4 * (q & 1); const f32x4 wv = *(const f32x4*)(p.in[8] + col);
                *(f32x4*)(p.out + (size_t)row * 1024 + col) = (f32x4){x[q][0] * rs * wv[0], x[q][1] * rs * wv[1], x[q][2] * rs * wv[2], x[q][3] * rs * wv[3]}; }
        }
    }
}

constexpr int GL_QG = 0, GL_KG = 16384, GL_KET = 32768, GL_VT = 49152, GL_AM = 57344, GL_ST = 65536, GL_OST = 81920, GL_DEC = 90112;
__device__ __forceinline__ void phase_gla(const Frame& F, const Params& p) {
    LAS unsigned char* lds = F.lds;
    const bf16_t* PA = (const bf16_t*)(p.ws + WS_PA);
    const int tid = F.tid, lane = F.lane, wave = F.wave, fr = lane & 15, fq = lane >> 4;
    const int kb = 16 * wave, vs = tid >> 3, v8 = tid & 7;
    for (int u = F.bid; u < 256; u += F.G) {
        const int b = u >> 5, hg = (u >> 2) & 7, d = (u >> 1) & 1, vh = u & 1;
        bf16_t* O = (bf16_t*)((unsigned char*)p.out + (d ? DO_Y1 : 0));
        for (int i = tid; i < 1024; i += 512) *(LAS u32x4*)(lds + GL_ST + i * 16) = (u32x4){0u, 0u, 0u, 0u};
        f32x4 S[4];
#pragma unroll
        for (int i = 0; i < 4; ++i) S[i] = (f32x4){0.f, 0.f, 0.f, 0.f};
        u32x4 qv[2], gv[2], vv;
        { const int r0 = chunk_row0(0, b, d); const bf16_t* rp = PA + (size_t)(r0 + lane) * 4096 + hg * 128 + kb;
#pragma unroll
          for (int i = 0; i < 2; ++i) { qv[i] = *(const u32x4*)(rp + 8 * i); gv[i] = *(const u32x4*)(rp + 1024 + d * 1024 + 8 * i); }
          vv = *(const u32x4*)(PA + (size_t)(r0 + vs) * 4096 + 3072 + hg * 128 + vh * 64 + v8 * 8); }
        for (int q = 0; q < 68; ++q) {
            const int r0 = chunk_row0(q, b, d); const bool lat = q >= 4;
            float gc[16], kk[16], qq[16];
#pragma unroll
            for (int i = 0; i < 2; ++i)
#pragma unroll
                for (int e = 0; e < 8; ++e) { const float g = bf_one(dw_elem(gv[i], e)); gc[8 * i + e] = g; kk[8 * i + e] = 1.f - __expf(g); qq[8 * i + e] = bf_one(dw_elem(qv[i], e)); }
            if (d == 0) {
#pragma unroll
                for (int o = 1; o < 64; o <<= 1)
#pragma unroll
                    for (int c = 0; c < 16; ++c) { const float t = __shfl_up(gc[c], o); if (lane >= o) gc[c] += t; }
            } else {
#pragma unroll
                for (int o = 1; o < 64; o <<= 1)
#pragma unroll
                    for (int c = 0; c < 16; ++c) { const float t = __shfl_down(gc[c], o); if (lane + o < 64) gc[c] += t; }
            }
            float qg[16], kg[16];
#pragma unroll
            for (int c = 0; c < 16; ++c) { const float gend = __shfl(gc[c], d ? 0 : 63);
                qg[c] = qq[c] * __expf(gc[c]); kg[c] = kk[c] * __expf(-gc[c]);
                const float ke = kk[c] * __expf(gend - gc[c]);
                *(LAS u16*)(lds + GL_KET + frag_off(kb + c, lane >> 3, 2) + (lane & 7) * 2) = (u16)(pk_bf16(ke, ke) & 0xffffu);
                if (lane == 0) *(LAS float*)(lds + GL_DEC + (kb + c) * 4) = __expf(gend); }
#pragma unroll
            for (int i = 0; i < 2; ++i) {
                *(LAS u32x4*)(lds + GL_QG + frag_off(lane, (kb >> 3) + i, 4)) = (u32x4){pk_bf16(qg[8 * i], qg[8 * i + 1]), pk_bf16(qg[8 * i + 2], qg[8 * i + 3]), pk_bf16(qg[8 * i + 4], qg[8 * i + 5]), pk_bf16(qg[8 * i + 6], qg[8 * i + 7])};
                *(LAS u32x4*)(lds + GL_KG + frag_off(lane, (kb >> 3) + i, 4)) = (u32x4){pk_bf16(kg[8 * i], kg[8 * i + 1]), pk_bf16(kg[8 * i + 2], kg[8 * i + 3]), pk_bf16(kg[8 * i + 4], kg[8 * i + 5]), pk_bf16(kg[8 * i + 6], kg[8 * i + 7])}; }
#pragma unroll
            for (int e = 0; e < 8; ++e) *(LAS u16*)(lds + GL_VT + frag_off(v8 * 8 + e, vs >> 3, 2) + (vs & 7) * 2) = dw_elem(vv, e);
            if (q + 1 < 68) { const int r1 = chunk_row0(q + 1, b, d); const bf16_t* rp = PA + (size_t)(r1 + lane) * 4096 + hg * 128 + kb;
#pragma unroll
                for (int i = 0; i < 2; ++i) { qv[i] = *(const u32x4*)(rp + 8 * i); gv[i] = *(const u32x4*)(rp + 1024 + d * 1024 + 8 * i); }
                vv = *(const u32x4*)(PA + (size_t)(r1 + vs) * 4096 + 3072 + hg * 128 + vh * 64 + v8 * 8); }
            __syncthreads();
            const int ott = wave >> 1, ovt0 = (wave & 1) * 2;
            f32x4 oacc[2] = {{0.f, 0.f, 0.f, 0.f}, {0.f, 0.f, 0.f, 0.f}};
            if (lat) {
                const int si = wave >> 1, tt0 = (wave & 1) * 2;
                bf16x8 af[4];
#pragma unroll
                for (int ks = 0; ks < 4; ++ks) af[ks] = ld_frag(lds, GL_KG, si, ks, 4, lane);
#pragma unroll
                for (int ts = 0; ts < 2; ++ts) { const int tt = tt0 + ts; f32x4 acc = {0.f, 0.f, 0.f, 0.f};
#pragma unroll
                    for (int ks = 0; ks < 4; ++ks) acc = mfma16(af[ks], ld_frag(lds, GL_QG, tt, ks, 4, lane), acc);
                    const int t = 16 * tt + fr, s0 = 16 * si + 4 * fq; float v[4];
#pragma unroll
                    for (int j = 0; j < 4; ++j) { const int s = s0 + j; const bool ok = d ? (s >= t) : (s <= t); v[j] = ok ? acc[j] : 0.f;
#if defined(DBG_GLA) && (DBG_GLA & 4)
                        v[j] = ok ? 1.f : 0.f;
#endif
                    }
                    *(LAS u32x2*)(lds + GL_AM + frag_off(t, s0 >> 3, 2) + (s0 & 7) * 2) = (u32x2){pk_bf16(v[0], v[1]), pk_bf16(v[2], v[3])}; }
#pragma unroll
                for (int ks = 0; ks < 4; ++ks) { const bf16x8 bf = ld_frag(lds, GL_QG, ott, ks, 4, lane);
#pragma unroll
                    for (int vsel = 0; vsel < 2; ++vsel) oacc[vsel] = mfma16(ld_frag(lds, GL_ST, ovt0 + vsel, ks, 4, lane), bf, oacc[vsel]); }
#if defined(DBG_GLA) && (DBG_GLA & 2)
                oacc[0] = (f32x4){0.f, 0.f, 0.f, 0.f}; oacc[1] = (f32x4){0.f, 0.f, 0.f, 0.f};
#endif
            }
            { const f32x4 dec = *(LAS f32x4*)(lds + GL_DEC + (16 * wave + 4 * fq) * 4);
#pragma unroll
              for (int vt = 0; vt < 4; ++vt) { S[vt][0] *= dec[0]; S[vt][1] *= dec[1]; S[vt][2] *= dec[2]; S[vt][3] *= dec[3]; }
#pragma unroll
              for (int ks = 0; ks < 2; ++ks) { const bf16x8 af = ld_frag(lds, GL_KET, wave, ks, 2, lane);
#pragma unroll
                  for (int vt = 0; vt < 4; ++vt) S[vt] = mfma16(af, ld_frag(lds, GL_VT, vt, ks, 2, lane), S[vt]); } }
            __syncthreads();
            if (lat) {
#pragma unroll
                for (int ks = 0; ks < 2; ++ks) { const bf16x8 bf = ld_frag(lds, GL_AM, ott, ks, 2, lane);
#pragma unroll
                    for (int vsel = 0; vsel < 2; ++vsel) {
#if defined(DBG_GLA) && (DBG_GLA & 1)
                        (void)bf;
#else
                        oacc[vsel] = mfma16(ld_frag(lds, GL_VT, ovt0 + vsel, ks, 2, lane), bf, oacc[vsel]);
#endif
                    } }
                const int t = 16 * ott + fr;
#pragma unroll
                for (int vsel = 0; vsel < 2; ++vsel) { const int v0 = 16 * (ovt0 + vsel) + 4 * fq;
                    *(LAS u32x2*)(lds + GL_OST + t * 128 + v0 * 2) = (u32x2){pk_bf16(oacc[vsel][0], oacc[vsel][1]), pk_bf16(oacc[vsel][2], oacc[vsel][3])}; }
            }
            { const int k0 = 16 * wave + 4 * fq;
#pragma unroll
              for (int vt = 0; vt < 4; ++vt) *(LAS u32x2*)(lds + GL_ST + frag_off(16 * vt + fr, k0 >> 3, 4) + (k0 & 7) * 2) = (u32x2){pk_bf16(S[vt][0], S[vt][1]), pk_bf16(S[vt][2], S[vt][3])}; }
            __syncthreads();
            if (lat) { const int t = tid >> 3, pc = tid & 7; const u32x4 v = *(LAS u32x4*)(lds + GL_OST + t * 128 + pc * 16);
                *(u32x4*)(O + (size_t)(r0 + t) * 1024 + hg * 128 + vh * 64 + pc * 8) = v; }
        }
        __syncthreads();
    }
}

__device__ __forceinline__ void phase_finish1(const Frame& F, const Params& p) {
    const bf16_t* O0 = (const bf16_t*)p.out; const bf16_t* O1 = (const bf16_t*)((const unsigned char*)p.out + DO_Y1);
    const bf16_t* SG = (const bf16_t*)(p.ws + WS_SG); bf16_t* A1 = (bf16_t*)(p.ws + WS_A1);
    const float* nw = p.in[21];
    const int c0 = F.lane * 16;
    for (int row = F.bid * 8 + F.wave; row < ML; row += F.G * 8) {
        const size_t o = (size_t)row * 1024 + c0;
        float v[16], sg[16]; float ss = 0.f;
#pragma unroll
        for (int i = 0; i < 2; ++i) { const u32x4 a = *(const u32x4*)(O0 + o + 8 * i), bq = *(const u32x4*)(O1 + o + 8 * i), s = *(const u32x4*)(SG + o + 8 * i);
#pragma unroll
            for (int e = 0; e < 8; ++e) { float x = bf_one(dw_elem(a, e)) + bf_one(dw_elem(bq, e));
#if defined(DBG_F1) && DBG_F1 == 1
                x = bf_one(dw_elem(a, e));
#elif defined(DBG_F1) && DBG_F1 == 2
                x = bf_one(dw_elem(bq, e));
#elif defined(DBG_F1) && DBG_F1 == 3
                x = bf_one(dw_elem(s, e));
#endif
#ifdef DBG_F1
                if (!(fabsf(x) < 1e30f)) x = 12345.f;
                v[8 * i + e] = x; ss = 128.f * (1.f - 1e-6f); sg[8 * i + e] = 1.f;
#else
                v[8 * i + e] = x; ss += x * x; sg[8 * i + e] = bf_one(dw_elem(s, e));
#endif
                } }
        ss += __shfl_xor(ss, 1); ss += __shfl_xor(ss, 2); ss += __shfl_xor(ss, 4);
        const float rs = rsqrtf(ss * (1.f / 128.f) + NORM_EPS);
#pragma unroll
        for (int i = 0; i < 2; ++i) { const f32x4 g0 = *(const f32x4*)(nw + c0 + 8 * i), g1 = *(const f32x4*)(nw + c0 + 8 * i + 4);
            *(u32x4*)(A1 + o + 8 * i) = (u32x4){pk_bf16(v[8 * i] * rs * g0[0] * sg[8 * i], v[8 * i + 1] * rs * g0[1] * sg[8 * i + 1]), pk_bf16(v[8 * i + 2] * rs * g0[2] * sg[8 * i + 2], v[8 * i + 3] * rs * g0[3] * sg[8 * i + 3]),
                                              pk_bf16(v[8 * i + 4] * rs * g1[0] * sg[8 * i + 4], v[8 * i + 5] * rs * g1[1] * sg[8 * i + 5]), pk_bf16(v[8 * i + 6] * rs * g1[2] * sg[8 * i + 6], v[8 * i + 7] * rs * g1[3] * sg[8 * i + 7])}; }
    }
}

constexpr int N_PHASES = 20;
#ifndef MK_ONE_LAUNCH
#define MK_ONE_LAUNCH 1
#endif
__global__ void __launch_bounds__(512, 2) fwd_kernel(Params p) {
    extern __shared__ __attribute__((aligned(16))) unsigned char lds_raw[];
    Frame F; F.lds = (LAS unsigned char*)lds_raw; F.tid = threadIdx.x; F.lane = F.tid & 63; F.wave = __builtin_amdgcn_readfirstlane(F.tid >> 6); F.bid = blockIdx.x; F.G = gridDim.x;
    volatile LAS unsigned* MISC = (volatile LAS unsigned*)(F.lds + LDS_MISC);
    if (F.tid < 4) MISC[F.tid] = 0u;
    __syncthreads();
    XcdBarrier bar = xcd_barrier_post((unsigned*)(p.ws + WS_CTL), MISC);
    const int lo = p.ph_lo, hi = p.ph_hi;
    unsigned char* ws = p.ws; unsigned char* dout = (unsigned char*)p.out;
    const float* MOD0 = (const float*)(ws + WS_MOD); const float* MOD1 = MOD0 + 9 * 6144;
    float* R = (float*)(ws + WS_R);
#define IN(k) (lo <= (k) && (k) < hi)
#define SEAM(k) do { if (IN((k) + 1)) xcd_barrier(bar); } while (0)
    if (IN(0)) { p0_prologue(F, p); SEAM(0); }
    if (IN(1)) { phase_norm(F, p.in[0], p.in[2], MA, p.in[6], MOD0, 0, 1024, (bf16_t*)(dout + DO_H)); SEAM(1); }
    if (IN(2)) { pg8::Gemm g{(const bf16_t*)(dout + DO_H), (const bf16_t*)(ws + WS_WIN0), MA, NIN0, 1024}; pg8::StaticOrder S; S.init(MA, NIN0, F.G, F.bid);
        EpiIn0 E{(bf16_t*)(ws + WS_XBC), (bf16_t*)(ws + WS_P4), (float*)(ws + WS_DT)}; pg8::gemm_phase<EpiIn0, pg8::StaticOrder>(F.lds, g, S, E); SEAM(2); }
    if (IN(3)) { phase_conv(F, p); SEAM(3); }
    if (IN(4)) { phase_ssd(F, p); SEAM(4); }
    if (IN(5)) { phase_finish0(F, p); SEAM(5); }
    if (IN(6)) { pg8::Gemm g{(const bf16_t*)(ws + WS_A2), (const bf16_t*)(ws + WS_WOUT0), MA, 1024, 2048}; pg8::StaticOrder S; S.init(MA, 1024, F.G, F.bid);
        EpiRes E{p.in[0], p.in[2], R, MOD0 + 2048}; pg8::gemm_phase<EpiRes, pg8::StaticOrder>(F.lds, g, S, E); SEAM(6); }
    if (IN(7)) { phase_norm(F, R, R + (size_t)ML * 1024, MA, p.in[7], MOD0, 3072, 4096, (bf16_t*)(dout + DO_H)); SEAM(7); }
    if (IN(8)) { pg8::Gemm g{(const bf16_t*)(dout + DO_H), (const bf16_t*)(ws + WS_WQ), MA, 2048, 1024}; pg8::StaticOrder S; S.init(MA, 2048, F.G, F.bid);
        EpiBf E{(bf16_t*)(ws + WS_Q0), 2048}; pg8::gemm_phase<EpiBf, pg8::StaticOrder>(F.lds, g, S, E); SEAM(8); }
    if (IN(9)) { phase_topk(F, p, 0, (const bf16_t*)(ws + WS_Q0), MA, (u16*)(dout + DO_IDX0), (float*)(dout + DO_GATE0)); SEAM(9); }
    if (IN(10)) { phase_gather<false>(F, p, 0, (const bf16_t*)(dout + DO_H), (const u16*)(dout + DO_IDX0), (const float*)(dout + DO_GATE0), MA, R); SEAM(10); }
    if (IN(11)) { phase_norm(F, R, R + (size_t)ML * 1024, MA, p.in[6] + 1024, MOD1, 0, 1024, (bf16_t*)(dout + DO_H)); SEAM(11); }
    if (IN(12)) { pg8::Gemm g{(const bf16_t*)(dout + DO_H), (const bf16_t*)(ws + WS_WIN1), MA, ODD_IN, 1024}; pg8::StaticOrder S; S.init(MA, ODD_IN, F.G, F.bid);
        EpiIn1 E{(bf16_t*)(ws + WS_PA), (bf16_t*)(ws + WS_SG), (const float*)(ws + WS_LB)}; pg8::gemm_phase<EpiIn1, pg8::StaticOrder>(F.lds, g, S, E); SEAM(12); }
    if (IN(13)) { phase_gla(F, p); SEAM(13); }
    if (IN(14)) { phase_finish1(F, p); SEAM(14); }
    if (IN(15)) { pg8::Gemm g{(const bf16_t*)(ws + WS_A1), (const bf16_t*)(ws + WS_WOUT1), ML, 1024, 1024}; pg8::StaticOrder S; S.init(ML, 1024, F.G, F.bid);
        EpiRes E{R, R, R, MOD1 + 2048}; pg8::gemm_phase<EpiRes, pg8::StaticOrder>(F.lds, g, S, E); SEAM(15); }
    if (IN(16)) { phase_norm(F, R, R, ML, p.in[7] + 1024, MOD1, 3072, 4096, (bf16_t*)(ws + WS_HF1)); convert_tables(F, p, 1); SEAM(16); }
    if (IN(17)) { pg8::Gemm g{(const bf16_t*)(ws + WS_HF1), (const bf16_t*)(ws + WS_WQ) + (size_t)2048 * 1024, ML, 2048, 1024}; pg8::StaticOrder S; S.init(ML, 2048, F.G, F.bid);
        EpiBf E{(bf16_t*)(ws + WS_Q1), 2048}; pg8::gemm_phase<EpiBf, pg8::StaticOrder>(F.lds, g, S, E); SEAM(17); }
    if (IN(18)) { phase_topk(F, p, 1, (const bf16_t*)(ws + WS_Q1), ML, (u16*)(ws + WS_IDX1), (float*)(ws + WS_GATE1)); SEAM(18); }
    if (IN(19)) { phase_gather<true>(F, p, 1, (const bf16_t*)(ws + WS_HF1), (const u16*)(ws + WS_IDX1), (const float*)(ws + WS_GATE1), ML, R); }
#undef IN
#undef SEAM
}


#ifdef DBG_STOP
__global__ void dump_kernel(const void* src, int is_f32, float* out, size_t n_src, size_t n) {
    for (size_t i = (size_t)blockIdx.x * blockDim.x + threadIdx.x; i < n; i += (size_t)gridDim.x * blockDim.x)
    {
#ifdef DBG_K
        float acc = 0.f;
        for (int k = 0; k < DBG_K; ++k) { const size_t j = i + (size_t)k * n; acc += is_f32 ? ((const float*)src)[j] : __uint_as_float(((unsigned)((const unsigned short*)src)[j]) << 16); }
        out[i] = acc;
#else
        out[i] = i < n_src ? (is_f32 ? ((const float*)src)[i] : __uint_as_float(((unsigned)((const unsigned short*)src)[i]) << 16)) : 0.f;
#endif
    }
}
#endif
extern "C" void kernel_launch(void* const* d_in, const int* in_sizes, int n_in, void* d_out, int out_size, void* d_ws, size_t ws_size, hipStream_t stream) {
    static int grid = 0;
    if (grid == 0) {
        if (n_in != 26 || out_size != ML * D || ws_size < WS_END) { fprintf(stderr, "kernel_launch: unexpected problem (n_in %d, out %d, ws %zu < %zu)\n", n_in, out_size, ws_size, (size_t)WS_END); grid = -1; return; }
        int dev = 0, cus = 0, per_cu = 0;
        if (hipGetDevice(&dev) != hipSuccess || hipDeviceGetAttribute(&cus, hipDeviceAttributeMultiprocessorCount, dev) != hipSuccess) { grid = -1; return; }
        if (hipFuncSetAttribute((const void*)fwd_kernel, hipFuncAttributeMaxDynamicSharedMemorySize, LDS_BYTES) != hipSuccess) { fprintf(stderr, "kernel_launch: hipFuncSetAttribute failed\n"); grid = -1; return; }
        if (hipOccupancyMaxActiveBlocksPerMultiprocessor(&per_cu, (const void*)fwd_kernel, 512, LDS_BYTES) != hipSuccess || per_cu < 1) { fprintf(stderr, "kernel_launch: occupancy query says %d\n", per_cu); (void)hipGetLastError(); grid = -1; return; }
        grid = cus;
    }
    if (grid < 0) return;
    (void)hipMemsetAsync((char*)d_ws + WS_CTL, 0, XCD_BAR_WORDS * sizeof(unsigned), stream);
    Params p{};
    for (int i = 0; i < 26; ++i) p.in[i] = (const float*)d_in[i];
    p.out = (float*)d_out; p.ws = (unsigned char*)d_ws;
#if MK_ONE_LAUNCH
    p.ph_lo = 0; p.ph_hi = N_PHASES;
    hipLaunchKernelGGL(fwd_kernel, dim3(grid), dim3(512), LDS_BYTES, stream, p);
#elif defined(DBG_STOP)
    for (int k = 0; k <= DBG_STOP; ++k) { p.ph_lo = k; p.ph_hi = k + 1; hipLaunchKernelGGL(fwd_kernel, dim3(grid), dim3(512), LDS_BYTES, stream, p); }
    hipLaunchKernelGGL(dump_kernel, dim3(2048), dim3(256), 0, stream, (const void*)((unsigned char*)d_ws + DBG_SRC), DBG_F32, (float*)d_out, (size_t)DBG_N, (size_t)ML * D);
#else
    for (int k = 0; k < N_PHASES; ++k) { p.ph_lo = k; p.ph_hi = k + 1; hipLaunchKernelGGL(fwd_kernel, dim3(grid), dim3(512), LDS_BYTES, stream, p); }
#endif
}
```

```cpp
#include <hip/hip_runtime.h>
#include <stdint.h>
#include <cstdio>

#define LAS __attribute__((address_space(3)))
typedef unsigned short u16;
typedef float f32x2 __attribute__((ext_vector_type(2)));
typedef unsigned u32x2 __attribute__((ext_vector_type(2)));
typedef __bf16 bf16v2 __attribute__((ext_vector_type(2)));

constexpr int D = 1024, NB = 8, SEQ = 4096, CTXL = 256;
constexpr int ML = NB * SEQ;
constexpr int MC = NB * CTXL;
constexpr int MA = ML + MC;
constexpr int EVEN_IN = 6176, ODD_IN = 5120;
constexpr int NIN0 = 6400;
constexpr float NORM_EPS = 1e-6f;

namespace pg8 {
#define PG8_LAS __attribute__((address_space(3)))
typedef unsigned short bf16_t;
typedef short bf16x8 __attribute__((ext_vector_type(8)));
typedef float f32x4 __attribute__((ext_vector_type(4)));
typedef unsigned u32x4 __attribute__((ext_vector_type(4)));
constexpr int BM = 256, BK = 64, HALF = 128, HTB = HALF * BK * 2  , STAGE_BYTES = 8 * HTB, NXCD = 8, WGM = 8;

__host__ __device__ __forceinline__ int lds_byte(int r, int c) { const int st = (r >> 4) * 2 + (c >> 5), rr = r & 15, cc = c & 31, ob = rr * 64 + cc * 2; return st * 1024 + (ob ^ (((ob >> 9) & 1) << 5)); }
__host__ __device__ __forceinline__ void stage_rc(int b, int& R, int& C) { const int st = b / 1024, sb = b % 1024, swz = sb ^ (((sb >> 9) & 1) << 5); R = (st >> 1) * 16 + swz / 64; C = (st & 1) * 32 + (swz % 64) / 2; }
__host__ __device__ __forceinline__ int perm32(int rho) { const int n = rho >> 4, i = rho & 15; return 8 * (i >> 2) + 4 * n + (i & 3); }

struct Unit { int pm, pn; };
struct Gemm { const bf16_t* A; const bf16_t* Bt; int M, N, K; };

struct StaticOrder {
    int nM, nN, nwg, G, c;
    __host__ __device__ void init(int M, int N, int G_, int c_) { nM = M / BM; nN = N / BM; nwg = nM * nN; G = G_; c = c_; }
    __host__ __device__ bool next(int i, Unit& u) const {
        const long L = (long)i * G + c; if (L >= nwg) return false;
        int wgid = (int)L; { const int q = nwg / NXCD, r = nwg % NXCD, xcd = wgid % NXCD, off = wgid / NXCD; wgid = (xcd < r ? xcd * (q + 1) : r * (q + 1) + (xcd - r) * q) + off; }
        const int nig = WGM * nN, gid = wgid / nig, fm = gid * WGM, gsz = (nM - fm) < WGM ? (nM - fm) : WGM;
        u.pm = fm + ((wgid % nig) % gsz); u.pn = (wgid % nig) / gsz; return true;
    }
    __device__ __forceinline__ void a_ready(const Unit&) const {}
    __device__ __forceinline__ void done(const Unit&) const {}
};


template <class Epi, class Sched>
__device__ __forceinline__ void gemm_phase(PG8_LAS unsigned char* lds, const Gemm g, const Sched& S, const Epi& E) {
    const int tid = threadIdx.x, wid = __builtin_amdgcn_readfirstlane(tid >> 6), lane = tid & 63, wr = wid >> 2, wc = wid & 3, fr = lane & 15, fq = lane >> 4;
    const int K = g.K, nt = K / BK;
    unsigned voffA[2], voffB[2];
#pragma unroll
    for (int i = 0; i < 2; ++i) { int R, C; stage_rc(tid * 16 + i * 8192, R, C); const int Rb = Epi::PERM ? ((R & ~31) + perm32(R & 31)) : R;
        voffA[i] = (unsigned)(R * K + C) * 2u; voffB[i] = (unsigned)(Rb * K + C) * 2u; }
    const size_t kstep = (size_t)(BK * 2);
    const size_t hstep = (size_t)HALF * K * 2;
    const size_t tstep = 2 * hstep;
    const unsigned ldsw = (unsigned)wid * 1024u;
    const int aoff = lds_byte(wr * 64 + fr, fq * 8), boff = lds_byte(wc * 32 + fr, fq * 8);
#define PG8_SA(b, h) (((b) * 2 + (h)) * HTB)
#define PG8_SB(b, h) ((4 + (b) * 2 + (h)) * HTB)
#define PG8_STAGE(bufoff, gbase, voff) do { _Pragma("unroll") for (int _i = 0; _i < 2; ++_i) \
        __builtin_amdgcn_global_load_lds((const unsigned*)((const char*)(gbase) + (voff)[_i]), (PG8_LAS unsigned*)(lds + (bufoff) + ldsw + _i * 8192), 16, 0, 0); } while (0)
#define PG8_LDA(dst, b, h) do { _Pragma("unroll") for (int m = 0; m < 4; ++m) _Pragma("unroll") for (int k = 0; k < 2; ++k) dst[m][k] = *(const PG8_LAS bf16x8*)(lds + PG8_SA(b, h) + aoff + m * 2048 + k * 1024); } while (0)
#define PG8_LDB(dst, b, h) do { _Pragma("unroll") for (int n = 0; n < 2; ++n) _Pragma("unroll") for (int k = 0; k < 2; ++k) dst[n][k] = *(const PG8_LAS bf16x8*)(lds + PG8_SB(b, h) + boff + n * 2048 + k * 1024); } while (0)
#define PG8_MMA(ai, bj, At, Bt) do { __builtin_amdgcn_s_setprio(1); _Pragma("unroll") for (int m = 0; m < 4; ++m) _Pragma("unroll") for (int n = 0; n < 2; ++n) _Pragma("unroll") for (int k = 0; k < 2; ++k) \
        acc[ai][bj][m][n] = __builtin_amdgcn_mfma_f32_16x16x32_bf16(Bt[n][k], At[m][k], acc[ai][bj][m][n], 0, 0, 0); __builtin_amdgcn_s_setprio(0); } while (0)
#define PG8_WAIT_V(n) asm volatile("s_waitcnt vmcnt(" #n ")" ::: "memory")
#define PG8_WAIT_L(n) asm volatile("s_waitcnt lgkmcnt(" #n ")" ::: "memory")
#define PG8_BAR __builtin_amdgcn_s_barrier()
#define PG8_SCHED __builtin_amdgcn_sched_barrier(0)
    Unit cur, nxt; int ui = 0;
    if (!S.next(0, cur)) return;
    f32x4 acc[2][2][4][2];
#pragma unroll
    for (int a = 0; a < 2; ++a)
#pragma unroll
        for (int b = 0; b < 2; ++b)
#pragma unroll
            for (int m = 0; m < 4; ++m)
#pragma unroll
                for (int n = 0; n < 2; ++n) acc[a][b][m][n] = (f32x4){0.f, 0.f, 0.f, 0.f};
    bf16x8 At[4][2], B0[2][2], B1[2][2];
    const char* cA = (const char*)g.A + (size_t)cur.pm * tstep; const char* cB = (const char*)g.Bt + (size_t)cur.pn * tstep;
    S.a_ready(cur);
    PG8_STAGE(PG8_SB(0, 0), cB, voffB); PG8_STAGE(PG8_SA(0, 0), cA, voffA); PG8_STAGE(PG8_SB(0, 1), cB + hstep, voffB); PG8_STAGE(PG8_SA(0, 1), cA + hstep, voffA);
    if (wr == 1) PG8_BAR;
    PG8_WAIT_V(4); PG8_BAR;
    PG8_STAGE(PG8_SB(1, 0), cB + kstep, voffB); PG8_STAGE(PG8_SA(1, 0), cA + kstep, voffA); PG8_STAGE(PG8_SB(1, 1), cB + hstep + kstep, voffB);
    PG8_WAIT_V(6); PG8_BAR;
    for (;;) {
        const bool has_next = S.next(ui + 1, nxt);
        const char* nA = has_next ? (const char*)g.A + (size_t)nxt.pm * tstep : cA; const char* nB = has_next ? (const char*)g.Bt + (size_t)nxt.pn * tstep : cB;
        for (int t = 0; t < nt; t += 2) {
            const bool last = (t == nt - 2);
            const char* a1 = cA + (size_t)(t + 1) * kstep;
            const char* a2 = last ? nA : cA + (size_t)(t + 2) * kstep; const char* b2 = last ? nB : cB + (size_t)(t + 2) * kstep;
            const char* a3 = a2 + kstep; const char* b3 = b2 + kstep;
            if (last && has_next) S.a_ready(nxt);
            PG8_LDB(B0, 0, 0); PG8_SCHED; PG8_LDA(At, 0, 0); PG8_STAGE(PG8_SA(1, 1), a1 + hstep, voffA);
            PG8_WAIT_L(8); PG8_BAR; PG8_WAIT_L(0); PG8_MMA(0, 0, At, B0); PG8_BAR; PG8_SCHED;
            PG8_LDB(B1, 0, 1); PG8_STAGE(PG8_SB(0, 0), b2, voffB);
            PG8_BAR; PG8_WAIT_L(0); PG8_MMA(0, 1, At, B1); PG8_BAR;
            PG8_LDA(At, 0, 1); PG8_STAGE(PG8_SA(0, 0), a2, voffA);
            PG8_BAR; PG8_WAIT_L(0); PG8_MMA(1, 0, At, B0); PG8_BAR; PG8_SCHED;
            PG8_STAGE(PG8_SB(0, 1), b2 + hstep, voffB);
            PG8_WAIT_V(6); PG8_BAR; PG8_MMA(1, 1, At, B1); PG8_BAR;
            PG8_LDB(B0, 1, 0); PG8_SCHED; PG8_LDA(At, 1, 0); PG8_STAGE(PG8_SA(0, 1), a2 + hstep, voffA);
            PG8_WAIT_L(8); PG8_BAR; PG8_WAIT_L(0); PG8_MMA(0, 0, At, B0); PG8_BAR; PG8_SCHED;
            PG8_LDB(B1, 1, 1); PG8_STAGE(PG8_SB(1, 0), b3, voffB);
            PG8_BAR; PG8_WAIT_L(0); PG8_MMA(0, 1, At, B1); PG8_BAR;
            PG8_LDA(At, 1, 1); PG8_STAGE(PG8_SA(1, 0), a3, voffA);
            PG8_BAR; PG8_WAIT_L(0); PG8_MMA(1, 0, At, B0); PG8_BAR; PG8_SCHED;
            PG8_STAGE(PG8_SB(1, 1), b3 + hstep, voffB);
            PG8_WAIT_V(6); PG8_BAR; PG8_MMA(1, 1, At, B1); PG8_BAR;
        }
        if constexpr (!Epi::AFTER_DRAIN) { E(acc, cur, wr, wc, fr, fq); S.done(cur); }
        if (!has_next) break;
#pragma unroll
        for (int a = 0; a < 2; ++a)
#pragma unroll
            for (int b = 0; b < 2; ++b)
#pragma unroll
                for (int m = 0; m < 4; ++m)
#pragma unroll
                    for (int n = 0; n < 2; ++n) acc[a][b][m][n] = (f32x4){0.f, 0.f, 0.f, 0.f};
        cur = nxt; cA = nA; cB = nB; ++ui;
    }
    PG8_WAIT_V(0);
    if (wr == 0) PG8_BAR;
    PG8_BAR;
    if constexpr (Epi::AFTER_DRAIN) { E.fused(acc, cur, wr, wc, fr, fq, lds, wid, lane); S.done(cur); }
#undef PG8_SA
#undef PG8_SB
#undef PG8_STAGE
#undef PG8_LDA
#undef PG8_LDB
#undef PG8_MMA
#undef PG8_WAIT_V
#undef PG8_WAIT_L
#undef PG8_BAR
#undef PG8_SCHED
}
}

using pg8::bf16_t; using pg8::bf16x8; using pg8::f32x4; using pg8::u32x4;

#define XB_TMO      128
#define XB_XCNT(j)  (256  + 64 * (j))
#define XB_XSUB(j)  (1280 + 64 * (j))
#define XB_XGEN(j)  (2304 + 64 * (j))
#define XB_TOP      3328
#define XB_TOPGEN   3392
#define XCD_BAR_WORDS 3456
#define XB_SPIN_CAP (1u << 18)

__device__ __forceinline__ unsigned xb_ld(unsigned* p)              { return __hip_atomic_load(p, __ATOMIC_RELAXED, __HIP_MEMORY_SCOPE_AGENT); }
__device__ __forceinline__ unsigned xb_add(unsigned* p, unsigned v) { return __hip_atomic_fetch_add(p, v, __ATOMIC_RELAXED, __HIP_MEMORY_SCOPE_AGENT); }
__device__ __forceinline__ unsigned xb_xcc_id() { return (unsigned)__builtin_amdgcn_s_getreg((3 << 11) | 20) & 0xFu; }
#define XB_SPIN(cond, bar) do { unsigned _sp = 0; while (cond) { __builtin_amdgcn_s_sleep(1); \
    if ((++_sp & 255u) == 0u) { if (xb_ld(&(bar)[XB_TMO])) break; if (_sp > XB_SPIN_CAP) { atomicAdd(&(bar)[XB_TMO], 1u); break; } } } } while (0)

struct XcdBarrier {
    unsigned* bar; unsigned x;
    volatile LAS unsigned* st;
};

__device__ __forceinline__ XcdBarrier xcd_barrier_post(unsigned* bar, volatile LAS unsigned* st) {
    XcdBarrier b; b.bar = bar; b.x = xb_xcc_id(); b.st = st;
    if (threadIdx.x == 0) (void)xb_add(&bar[XB_XCNT(b.x)], 1u);
    return b;
}
__device__ __forceinline__ void xcd_barrier_complete(unsigned* bar, unsigned x, unsigned& nloc, unsigned& nx) {
    const unsigned G = gridDim.x * gridDim.y * gridDim.z;
    unsigned sum, cnt, mine, sp = 0u;
    for (;;) {
        sum = 0u; cnt = 0u; mine = 0u;
#pragma unroll
        for (unsigned j = 0; j < 16; ++j) { const unsigned c = xb_ld(&bar[XB_XCNT(j)]); sum += c; cnt += (c > 0u) ? 1u : 0u; mine = (j == x) ? c : mine; }
        if (sum == G) break;
        __builtin_amdgcn_s_sleep(1);
        if ((++sp & 255u) == 0u) { if (xb_ld(&bar[XB_TMO])) break; if (sp > XB_SPIN_CAP) { atomicAdd(&bar[XB_TMO], 1u); break; } }
    }
    nloc = mine > 0u ? mine : 1u; nx = cnt > 0u ? cnt : 1u;
}

__device__ __forceinline__ void xcd_barrier(const XcdBarrier& b) {
    asm volatile("s_waitcnt vmcnt(0)" ::: "memory");
    __syncthreads();
    if (threadIdx.x == 0) {
        unsigned* bar = b.bar;
        __builtin_amdgcn_s_waitcnt(0);
        unsigned nloc = b.st[0], nx = b.st[1];
        if (nloc == 0u) { xcd_barrier_complete(bar, b.x, nloc, nx); b.st[0] = nloc; b.st[1] = nx; }
        const unsigned old = xb_add(&bar[XB_XSUB(b.x)], 1u);
        const unsigned gen = old / nloc;
        if (old + 1u == (gen + 1u) * nloc) {
            __builtin_amdgcn_fence(__ATOMIC_RELEASE, "agent");
            asm volatile("s_waitcnt vmcnt(0)" ::: "memory");
            const unsigned og = xb_add(&bar[XB_TOP], 1u);
            const unsigned tg = og / nx;
            if (og + 1u == (tg + 1u) * nx) xb_add(&bar[XB_TOPGEN], 1u);
            else XB_SPIN(xb_ld(&bar[XB_TOPGEN]) == tg, bar);
            __builtin_amdgcn_fence(__ATOMIC_ACQUIRE, "agent");
            xb_add(&bar[XB_XGEN(b.x)], 1u);
            asm volatile("s_waitcnt vmcnt(0)" ::: "memory");
        } else {
            XB_SPIN(xb_ld(&bar[XB_XGEN(b.x)]) == gen, bar);
            __builtin_amdgcn_fence(__ATOMIC_ACQUIRE, "agent");
            asm volatile("s_waitcnt vmcnt(0)" ::: "memory");
        }
    }
    __syncthreads();
}

__device__ __forceinline__ unsigned pk_bf16(float lo, float hi) { bf16v2 v = {(__bf16)lo, (__bf16)hi}; return __builtin_bit_cast(unsigned, v); }
__device__ __forceinline__ float bf_lo(unsigned u) { return __uint_as_float(u << 16); }
__device__ __forceinline__ float bf_hi(unsigned u) { return __uint_as_float(u & 0xffff0000u); }
__device__ __forceinline__ float bf_one(u16 u) { return __uint_as_float(((unsigned)u) << 16); }
__device__ __forceinline__ float fast_rcp(float x) { return __builtin_amdgcn_rcpf(x); }
__device__ __forceinline__ float silu_f(float x) { return x * fast_rcp(1.f + __expf(-x)); }
__device__ __forceinline__ float sigmoid_f(float x) { return fast_rcp(1.f + __expf(-x)); }
__device__ __forceinline__ float wave_sum(float v) {
#pragma unroll
    for (int o = 32; o; o >>= 1) v += __shfl_xor(v, o);
    return v;
}
__device__ __forceinline__ u32x4 pk8(const f32x4& a, const f32x4& b) { return (u32x4){pk_bf16(a[0], a[1]), pk_bf16(a[2], a[3]), pk_bf16(b[0], b[1]), pk_bf16(b[2], b[3])}; }
__device__ __forceinline__ int frag_off(int r, int k8, int KB) { return ((r >> 4) * KB + (k8 >> 2)) * 1024 + (((k8 & 3) << 4) + (r & 15)) * 16; }
__device__ __forceinline__ bf16x8 ld_frag(LAS unsigned char* lds, int base, int rt, int ks, int KB, int lane) { return *(const LAS bf16x8*)(lds + base + (rt * KB + ks) * 1024 + lane * 16); }
__device__ __forceinline__ f32x4 mfma16(bf16x8 a, bf16x8 b, f32x4 c) { return __builtin_amdgcn_mfma_f32_16x16x32_bf16(a, b, c, 0, 0, 0); }

#define EPI_ARGS const f32x4 (&acc)[2][2][4][2], const pg8::Unit& u, int wr, int wc, int fr, int fq

struct EpiIn0 {
    static constexpr bool PERM = true, AFTER_DRAIN = false;
    bf16_t* XBC; bf16_t* P4; float* DT;
    __device__ __forceinline__ void operator()(EPI_ARGS) const {
        const int row0 = u.pm * 256 + wr * 64 + fr, cl = wc * 32 + 8 * fq, pn = u.pn;
        if (pn < 8) {
#pragma unroll
            for (int ai = 0; ai < 2; ++ai)
#pragma unroll
                for (int m = 0; m < 4; ++m) { bf16_t* rp = XBC + (size_t)(row0 + ai * 128 + m * 16) * 2048 + pn * 256 + cl;
#pragma unroll
                    for (int bj = 0; bj < 2; ++bj) *(u32x4*)(rp + bj * 128) = pk8(acc[ai][bj][m][0], acc[ai][bj][m][1]); }
        } else if (pn < 16) {
#pragma unroll
            for (int ai = 0; ai < 2; ++ai)
#pragma unroll
                for (int m = 0; m < 4; ++m) { bf16_t* rp = P4 + (size_t)(row0 + ai * 128 + m * 16) * 3072 + (pn - 8) * 128 + cl;
                    *(u32x4*)rp = pk8(acc[ai][0][m][0] * acc[ai][1][m][0], acc[ai][0][m][1] * acc[ai][1][m][1]); }
        } else if (pn < 20) {
#pragma unroll
            for (int ai = 0; ai < 2; ++ai)
#pragma unroll
                for (int m = 0; m < 4; ++m) { bf16_t* rp = P4 + (size_t)(row0 + ai * 128 + m * 16) * 3072 + 1024 + (pn - 16) * 256 + cl;
#pragma unroll
                    for (int bj = 0; bj < 2; ++bj) *(u32x4*)(rp + bj * 128) = pk8(acc[ai][bj][m][0], acc[ai][bj][m][1]); }
        } else if (pn < 24) {
#pragma unroll
            for (int ai = 0; ai < 2; ++ai)
#pragma unroll
                for (int m = 0; m < 4; ++m) { bf16_t* rp = P4 + (size_t)(row0 + ai * 128 + m * 16) * 3072 + 2048 + (pn - 20) * 256 + cl;
#pragma unroll
                    for (int bj = 0; bj < 2; ++bj) { f32x4 a = acc[ai][bj][m][0], b = acc[ai][bj][m][1];
#pragma unroll
                        for (int i = 0; i < 4; ++i) { a[i] = silu_f(a[i]); b[i] = silu_f(b[i]); }
                        *(u32x4*)(rp + bj * 128) = pk8(a, b); } }
        } else if (wc == 0) {
#pragma unroll
            for (int ai = 0; ai < 2; ++ai)
#pragma unroll
                for (int m = 0; m < 4; ++m) { float* rp = DT + (size_t)(row0 + ai * 128 + m * 16) * 32 + 8 * fq;
                    *(f32x4*)rp = acc[ai][0][m][0]; *(f32x4*)(rp + 4) = acc[ai][0][m][1]; }
        }
    }
};
template <bool SRC_BF>
struct EpiResT {
    static constexpr bool PERM = true, AFTER_DRAIN = false;
    const float* srcL; const float* srcC; bf16_t* R; const float* gate;
    __device__ __forceinline__ void operator()(EPI_ARGS) const {
        const int row0 = u.pm * 256 + wr * 64 + fr, col0 = u.pn * 256 + wc * 32 + 8 * fq;
        const int j = u.pm < 128 ? (u.pm >> 4) : 8;
        const float* gp = gate + (size_t)j * 6144 + col0;
        f32x4 gv[2][2];
#pragma unroll
        for (int bj = 0; bj < 2; ++bj)
#pragma unroll
            for (int n = 0; n < 2; ++n) gv[bj][n] = *(const f32x4*)(gp + bj * 128 + 4 * n);
#pragma unroll
        for (int ai = 0; ai < 2; ++ai)
#pragma unroll
            for (int m = 0; m < 4; ++m) { const int row = row0 + ai * 128 + m * 16; bf16_t* rp = R + (size_t)row * 1024 + col0;
#pragma unroll
                for (int bj = 0; bj < 2; ++bj) { f32x4 s0, s1;
                    if (SRC_BF) { const u32x4 sv = *(const u32x4*)(rp + bj * 128); s0 = (f32x4){bf_lo(sv[0]), bf_hi(sv[0]), bf_lo(sv[1]), bf_hi(sv[1])}; s1 = (f32x4){bf_lo(sv[2]), bf_hi(sv[2]), bf_lo(sv[3]), bf_hi(sv[3])}; }
                    else { const float* sp = (row < ML ? srcL + (size_t)row * 1024 : srcC + (size_t)(row - ML) * 1024) + col0 + bj * 128; s0 = *(const f32x4*)sp; s1 = *(const f32x4*)(sp + 4); }
                    *(u32x4*)(rp + bj * 128) = pk8(s0 + gv[bj][0] * acc[ai][bj][m][0], s1 + gv[bj][1] * acc[ai][bj][m][1]); } }
    }
};
struct EpiBf {
    static constexpr bool PERM = true, AFTER_DRAIN = false;
    bf16_t* O; int ldc;
    __device__ __forceinline__ void operator()(EPI_ARGS) const {
        const int row0 = u.pm * 256 + wr * 64 + fr, col0 = u.pn * 256 + wc * 32 + 8 * fq;
#pragma unroll
        for (int ai = 0; ai < 2; ++ai)
#pragma unroll
            for (int m = 0; m < 4; ++m) { bf16_t* rp = O + (size_t)(row0 + ai * 128 + m * 16) * ldc + col0;
#pragma unroll
                for (int bj = 0; bj < 2; ++bj) *(u32x4*)(rp + bj * 128) = pk8(acc[ai][bj][m][0], acc[ai][bj][m][1]); }
    }
};
struct EpiIn1 {
    static constexpr bool PERM = true, AFTER_DRAIN = false;
    bf16_t* PA; bf16_t* SG; const float* LB;
    __device__ __forceinline__ void operator()(EPI_ARGS) const {
        const int row0 = u.pm * 256 + wr * 64 + fr, cl = wc * 32 + 8 * fq, pn = u.pn, grp = pn >> 2, cg = (pn & 3) * 256 + cl;
        if (grp == 4 && u.pm >= 128) return;
#pragma unroll
        for (int bj = 0; bj < 2; ++bj) {
            f32x4 lb0 = {0.f, 0.f, 0.f, 0.f}, lb1 = {0.f, 0.f, 0.f, 0.f};
            if (grp == 1 || grp == 2) { const float* lp = LB + (grp - 1) * 1024 + cg + bj * 128; lb0 = *(const f32x4*)lp; lb1 = *(const f32x4*)(lp + 4); }
#pragma unroll
            for (int ai = 0; ai < 2; ++ai)
#pragma unroll
                for (int m = 0; m < 4; ++m) { const size_t row = (size_t)(row0 + ai * 128 + m * 16);
                    f32x4 a = acc[ai][bj][m][0], b = acc[ai][bj][m][1];
                    if (grp == 0) {
#pragma unroll
                        for (int i = 0; i < 4; ++i) { a[i] = silu_f(a[i]) * 0.08838834764831845f; b[i] = silu_f(b[i]) * 0.08838834764831845f; }
                    } else if (grp == 1 || grp == 2) {
#pragma unroll
                        for (int i = 0; i < 4; ++i) { a[i] = __logf(lb0[i] + (1.f - lb0[i]) * sigmoid_f(a[i])); b[i] = __logf(lb1[i] + (1.f - lb1[i]) * sigmoid_f(b[i])); }
                    } else if (grp == 4) {
#pragma unroll
                        for (int i = 0; i < 4; ++i) { a[i] = silu_f(a[i]); b[i] = silu_f(b[i]); }
                    }
                    bf16_t* rp = (grp == 4) ? SG + row * 1024 + cg + bj * 128 : PA + row * 4096 + grp * 1024 + cg + bj * 128;
                    *(u32x4*)rp = pk8(a, b); }
        }
    }
};

constexpr size_t MiB = (size_t)1 << 20;
constexpr size_t WS_CTL = 0;
constexpr size_t WS_MOD = 65536;
constexpr size_t WS_LB = WS_MOD + (size_t)2 * 9 * 6144 * 4;
constexpr size_t WS_WIN0 = 1 * MiB;
constexpr size_t WS_WOUT0 = WS_WIN0 + (size_t)NIN0 * 1024 * 2;
constexpr size_t WS_WIN1 = WS_WOUT0 + (size_t)1024 * 2048 * 2;
constexpr size_t WS_WOUT1 = WS_WIN1 + (size_t)5120 * 1024 * 2;
constexpr size_t WS_WQ = WS_WOUT1 + (size_t)1024 * 1024 * 2;
constexpr size_t WS_KEYS = WS_WQ + (size_t)2 * 2048 * 1024 * 2;
constexpr size_t WS_WEND = WS_KEYS + (size_t)2 * 8 * 2 * 128 * 128 * 2;
static_assert(WS_WEND <= 39 * MiB, "weights");
constexpr size_t WS_TAB = 39 * MiB;
constexpr size_t WS_Z1 = 103 * MiB;
constexpr size_t WS_Z2 = 239 * MiB;
constexpr size_t WS_R = 375 * MiB;
constexpr size_t WS_END = 511 * MiB;
constexpr size_t WS_XBC = WS_Z1;
constexpr size_t WS_A2 = WS_Z1;
constexpr size_t WS_Q0 = WS_Z1;
constexpr size_t WS_P4 = WS_Z2;
constexpr size_t WS_DT = 443 * MiB;
constexpr size_t WS_YC = 448 * MiB;
constexpr size_t WS_PA = WS_Z1;
constexpr size_t WS_SG = WS_TAB;
constexpr size_t WS_A1 = WS_Z1;
constexpr size_t WS_HF1 = WS_Z1;
constexpr size_t WS_IDX1 = WS_Z1 + 64 * MiB;
constexpr size_t WS_GATE1 = WS_Z1 + 72 * MiB;
constexpr size_t WS_Q1 = WS_Z2;
constexpr size_t WS_PART0 = WS_Z1;
constexpr size_t WS_ACT0 = WS_Z2;
constexpr size_t WS_PART1 = WS_Z2;
constexpr size_t WS_ACT1 = WS_Z1 + 88 * MiB;
constexpr size_t DO_SU0 = 94 * MiB;
constexpr size_t WS_SU1 = WS_Z1 + 104 * MiB;
constexpr size_t WS_H8_0 = WS_Z2 + 17 * MiB;
constexpr size_t WS_HS_0 = WS_H8_0 + 34 * MiB;
constexpr size_t DO_H8_1 = 0;
constexpr size_t DO_HS_1 = 32 * MiB;
constexpr size_t ACT_SA = (size_t)8 * MiB;
constexpr size_t WS_OUT0 = WS_Z1;
constexpr size_t WS_OUT1 = WS_Z2;
constexpr size_t CTL_BYTES = 65536;
constexpr size_t DO_H = 0;
constexpr size_t DO_Y1 = 64 * MiB;
constexpr size_t DO_IDX0 = 68 * MiB;
constexpr size_t DO_GATE0 = 77 * MiB;
constexpr int LDS_BYTES = 163840;
constexpr int LDS_MISC = 163840 - 512;

struct Params { const float* in[26]; float* out; unsigned char* ws; int ph_lo, ph_hi, rep, pad; };
struct Frame { LAS unsigned char* lds; int tid, lane, wave, bid, G; };

struct TrTile { const float* src; bf16_t* dst; int ld, K, k0, c0, nv, n0; };
__device__ __forceinline__ void tr_load(const Frame& F, const TrTile& t, f32x4 (&v)[2]) {
    const int kk = F.tid >> 4, n4 = (F.tid & 15) * 4;
#pragma unroll
    for (int i = 0; i < 2; ++i) { v[i] = (f32x4){0.f, 0.f, 0.f, 0.f}; if (n4 < t.nv) v[i] = *(const f32x4*)(t.src + (size_t)(t.k0 + kk + 32 * i) * t.ld + t.c0 + n4); }
}
__device__ __forceinline__ void tr_finish(const Frame& F, const TrTile& t, const f32x4 (&v)[2]) {
    LAS float* tile = (LAS float*)F.lds;
    const int kk = F.tid >> 4, n4 = (F.tid & 15) * 4;
#pragma unroll
    for (int i = 0; i < 2; ++i) { const int k = kk + 32 * i; tile[k * 65 + n4] = v[i][0]; tile[k * 65 + n4 + 1] = v[i][1]; tile[k * 65 + n4 + 2] = v[i][2]; tile[k * 65 + n4 + 3] = v[i][3]; }
    __syncthreads();
    const int n = F.tid >> 3, k8 = F.tid & 7;
    float f[8];
#pragma unroll
    for (int e = 0; e < 8; ++e) f[e] = tile[(8 * k8 + e) * 65 + n];
    *(u32x4*)(t.dst + (size_t)(t.n0 + n) * t.K + t.k0 + 8 * k8) = (u32x4){pk_bf16(f[0], f[1]), pk_bf16(f[2], f[3]), pk_bf16(f[4], f[5]), pk_bf16(f[6], f[7])};
    __syncthreads();
}
__device__ __forceinline__ TrTile tr_decode(const Params& p, int u) {
    unsigned char* ws = p.ws; TrTile t; int nt, kt; t.nv = 64;
    if (u < 1600) { nt = u >> 4; kt = u & 15; t.src = p.in[9]; t.ld = EVEN_IN; t.K = 1024; t.dst = (bf16_t*)(ws + WS_WIN0);
        if (nt < 32) t.c0 = 4096 + 64 * nt;
        else if (nt < 64) { const int uu = nt - 32, j = uu >> 2, q = uu & 3; t.c0 = q < 2 ? 128 * j + 64 * q : 2048 + 128 * j + 64 * (q - 2); }
        else if (nt < 80) t.c0 = 1024 + 64 * (nt - 64);
        else if (nt < 96) t.c0 = 3072 + 64 * (nt - 80);
        else if (nt == 96) { t.c0 = 6144; t.nv = 32; }
        else { t.c0 = 0; t.nv = 0; } }
    else if (u < 2112) { const int v = u - 1600; nt = v >> 5; kt = v & 31; t.src = p.in[10]; t.ld = 1024; t.K = 2048; t.dst = (bf16_t*)(ws + WS_WOUT0); t.c0 = 64 * nt; }
    else if (u < 3392) { const int v = u - 2112; nt = v >> 4; kt = v & 15; t.src = p.in[18]; t.ld = ODD_IN; t.K = 1024; t.dst = (bf16_t*)(ws + WS_WIN1); t.c0 = 64 * nt; }
    else if (u < 3648) { const int v = u - 3392; nt = v >> 4; kt = v & 15; t.src = p.in[19]; t.ld = 1024; t.K = 1024; t.dst = (bf16_t*)(ws + WS_WOUT1); t.c0 = 64 * nt; }
    else { const int v = u - 3648, layer = v >> 9, w = v & 511; nt = w >> 4; kt = w & 15; t.src = p.in[22] + (size_t)layer * 1024 * 2048; t.ld = 2048; t.K = 1024; t.dst = (bf16_t*)(ws + WS_WQ) + (size_t)layer * 2048 * 1024; t.c0 = 64 * nt; }
    t.k0 = kt * 64; t.n0 = nt * 64; return t;
}
__device__ __forceinline__ void cvt8(const float* __restrict__ s, bf16_t* __restrict__ d) {
    const f32x4 a = *(const f32x4*)s, b = *(const f32x4*)(s + 4); *(u32x4*)d = pk8(a, b);
}
__device__ __forceinline__ unsigned pack_i8x4(const f32x4& x, float sc) {
    unsigned w = 0;
#pragma unroll
    for (int e = 0; e < 4; ++e) { const int q = max(-127, min(127, __float2int_rn(x[e] * sc))); w |= ((unsigned)q & 0xffu) << (8 * e); }
    return w;
}
constexpr size_t TAB_V8 = (size_t)16 * MiB, TAB_SCU = (size_t)32 * MiB, TAB_SCV = TAB_SCU + 65536, TAB_SLICE = (size_t)2 * MiB;
template <int NR>
__device__ __forceinline__ void convert_rows(const Frame& F, const Params& p, int layer, const int (&rows)[NR]) {
    unsigned char* tab = p.ws + WS_TAB;
    f32x4 x[NR][4];
#pragma unroll
    for (int k = 0; k < NR; ++k) { const int t = rows[k] >> 14, r = rows[k] & 16383;
        const float* sp = (t ? p.in[25] : p.in[24]) + (size_t)layer * 16384 * 1024 + (size_t)r * 1024 + 16 * F.lane;
#pragma unroll
        for (int i = 0; i < 4; ++i) x[k][i] = *(const f32x4*)(sp + 4 * i); }
#pragma unroll
    for (int k = 0; k < NR; ++k) { const int t = rows[k] >> 14, r = rows[k] & 16383; float am = 0.f;
#pragma unroll
        for (int i = 0; i < 4; ++i) am = fmaxf(am, fmaxf(fmaxf(fabsf(x[k][i][0]), fabsf(x[k][i][1])), fmaxf(fabsf(x[k][i][2]), fabsf(x[k][i][3]))));
#pragma unroll
        for (int o = 32; o; o >>= 1) am = fmaxf(am, __shfl_xor(am, o));
        const float sc = am > 0.f ? 127.f / am : 1.f, inv = am > 0.f ? am * (1.f / 127.f) : 1.f;
        u32x4 o;
#pragma unroll
        for (int i = 0; i < 4; ++i) o[i] = pack_i8x4(x[k][i], sc);
        *(u32x4*)(tab + (t ? TAB_V8 : 0) + (size_t)(F.lane >> 3) * TAB_SLICE + (size_t)r * 128 + 16 * (F.lane & 7)) = o;
        if (F.lane == 0) ((float*)(tab + (t ? TAB_SCV : TAB_SCU)))[r] = inv; }
}
__device__ __forceinline__ void convert_tables(const Frame& F, const Params& p, int layer) {
    const int stride = F.G * 8;
    for (int row = F.bid * 8 + F.wave; row < 32768; row += 4 * stride) {
        if (row + 3 * stride < 32768) { const int rows[4] = {row, row + stride, row + 2 * stride, row + 3 * stride}; convert_rows<4>(F, p, layer, rows); }
        else for (int r2 = row; r2 < 32768; r2 += stride) { const int rows[1] = {r2}; convert_rows<1>(F, p, layer, rows); }
    }
}
__device__ __forceinline__ void convert_tables_dyn(const Frame& F, const Params& p, int layer, unsigned* head, int chunk0, int nchunks) {
    volatile LAS int* w = (volatile LAS int*)(F.lds + LDS_MISC + 64);
    for (;;) {
        if (F.tid == 0) *w = (int)__hip_atomic_fetch_add(head, 1u, __ATOMIC_RELAXED, __HIP_MEMORY_SCOPE_AGENT);
        __syncthreads();
        const int ticket = *w;
        __syncthreads();
        if (ticket >= nchunks) break;
        const int chunk = chunk0 + ticket;
#pragma unroll 1
        for (int rr = 0; rr < 8; rr += 4) { const int r0 = chunk * 64 + rr * 8 + F.wave; const int rows[4] = {r0, r0 + 8, r0 + 16, r0 + 24}; convert_rows<4>(F, p, layer, rows); }
    }
}
__device__ __forceinline__ void p0_prologue(const Frame& F, const Params& p) {
    unsigned char* ws = p.ws;
    for (int u = F.bid; u < 192; u += F.G) {
        const int layer = u / 96, cg = u % 96;
        LAS float* sc = (LAS float*)F.lds; LAS float* red = sc + 9 * 1024;
        for (int e = F.tid; e < 9216; e += 512) { const int j = e >> 10, k = e & 1023; const float cv = j < 8 ? p.in[1][j * 1024 + k] : p.in[3][k]; sc[e] = silu_f(cv); }
        __syncthreads();
        const int col = F.tid & 63, ks = F.tid >> 6;
        float acc[9];
#pragma unroll
        for (int j = 0; j < 9; ++j) acc[j] = 0.f;
        const float* wp = p.in[4] + (size_t)layer * 1024 * 6144 + (size_t)(ks * 128) * 6144 + cg * 64 + col;
        for (int k0 = 0; k0 < 128; k0 += 16) { float wv[16];
#pragma unroll
            for (int k = 0; k < 16; ++k) wv[k] = wp[(size_t)(k0 + k) * 6144];
#pragma unroll
            for (int k = 0; k < 16; ++k)
#pragma unroll
                for (int j = 0; j < 9; ++j) acc[j] += sc[j * 1024 + ks * 128 + k0 + k] * wv[k]; }
#pragma unroll
        for (int j = 0; j < 9; ++j) red[(ks * 9 + j) * 64 + col] = acc[j];
        __syncthreads();
        for (int e = F.tid; e < 576; e += 512) { const int j = e >> 6, c = e & 63; float s = 0.f;
#pragma unroll
            for (int q = 0; q < 8; ++q) s += red[(q * 9 + j) * 64 + c];
            ((float*)(ws + WS_MOD))[(size_t)(layer * 9 + j) * 6144 + cg * 64 + c] = s + p.in[5][layer * 6144 + cg * 64 + c]; }
        __syncthreads();
    }
    for (int e = F.bid * 512 + F.tid; e < 2048; e += F.G * 512) { const float l0 = p.in[20][e], l1 = p.in[20][2048 + e]; ((float*)(ws + WS_LB))[e] = fast_rcp(1.f + __expf(l0 - l1)); }
    if (F.bid < 4672) {
        TrTile cur = tr_decode(p, F.bid); f32x4 v[2]; tr_load(F, cur, v);
        for (int u = F.bid; u < 4672; u += F.G) {
            const int un = u + F.G; TrTile nxt = cur; f32x4 vn[2] = {{0.f, 0.f, 0.f, 0.f}, {0.f, 0.f, 0.f, 0.f}};
            if (un < 4672) { nxt = tr_decode(p, un); tr_load(F, nxt, vn); }
            tr_finish(F, cur, v);
            cur = nxt; v[0] = vn[0]; v[1] = vn[1];
        }
    }
    for (int i = F.bid * 512 + F.tid; i < 65536; i += F.G * 512) cvt8(p.in[23] + (size_t)8 * i, (bf16_t*)(ws + WS_KEYS) + (size_t)8 * i);
}

template <bool SRC_BF>
__device__ __forceinline__ void phase_norm(const Frame& F, const void* __restrict__ srcLv, const void* __restrict__ srcCv, int M, const float* __restrict__ w,
                                           const float* __restrict__ mod, int shift_off, int scale_off, bf16_t* __restrict__ H, unsigned char* __restrict__ H8 = nullptr, float* __restrict__ HS = nullptr,
                                           const bf16_t* __restrict__ POUT = nullptr, const float* __restrict__ pg5 = nullptr, bf16_t* __restrict__ RW = nullptr) {
    f32x4 wv4[4];
#pragma unroll
    for (int i = 0; i < 4; ++i) wv4[i] = *(const f32x4*)(w + 256 * i + 4 * F.lane);
    const int stride = F.G * 8;
    for (int row0 = F.bid * 8 + F.wave; row0 < M; row0 += 2 * stride) {
        f32x4 x[2][4]; u32x2 po[2][4]; f32x4 pg[2][4];
#pragma unroll
        for (int q = 0; q < 2; ++q) { const int row = row0 + q * stride;
            if (row < M) { const int j = row < ML ? (row >> 12) : 8;
#pragma unroll
                for (int i = 0; i < 4; ++i) { const int col = 256 * i + 4 * F.lane;
                    if (SRC_BF) { const u32x2 sv = *(const u32x2*)((const bf16_t*)srcLv + (size_t)row * 1024 + col); x[q][i] = (f32x4){bf_lo(sv[0]), bf_hi(sv[0]), bf_lo(sv[1]), bf_hi(sv[1])}; }
                    else { const float* sp = row < ML ? (const float*)srcLv + (size_t)row * 1024 : (const float*)srcCv + (size_t)(row - ML) * 1024; x[q][i] = *(const f32x4*)(sp + col); }
                    if (POUT) { pg[q][i] = *(const f32x4*)(pg5 + (size_t)j * 6144 + col); po[q][i] = *(const u32x2*)(POUT + (size_t)row * 1024 + col); } } } }
#pragma unroll
        for (int q = 0; q < 2; ++q) { const int row = row0 + q * stride;
            if (row < M) { const int j = row < ML ? (row >> 12) : 8; float ss = 0.f;
#pragma unroll
                for (int i = 0; i < 4; ++i) { const int col = 256 * i + 4 * F.lane;
                    if (POUT) { const f32x4 g5 = pg[q][i]; const u32x2 o = po[q][i];
                        x[q][i] = (f32x4){x[q][i][0] + g5[0] * bf_lo(o[0]), x[q][i][1] + g5[1] * bf_hi(o[0]), x[q][i][2] + g5[2] * bf_lo(o[1]), x[q][i][3] + g5[3] * bf_hi(o[1])};
                        *(u32x2*)(RW + (size_t)row * 1024 + col) = (u32x2){pk_bf16(x[q][i][0], x[q][i][1]), pk_bf16(x[q][i][2], x[q][i][3])}; }
                    ss += x[q][i][0] * x[q][i][0] + x[q][i][1] * x[q][i][1] + x[q][i][2] * x[q][i][2] + x[q][i][3] * x[q][i][3]; }
                ss = wave_sum(ss);
                const float rs = rsqrtf(ss * (1.f / 1024.f) + NORM_EPS);
                const float* mp = mod + (size_t)j * 6144;
                f32x4 h[4]; float am = 0.f;
#pragma unroll
                for (int i = 0; i < 4; ++i) { const int col = 256 * i + 4 * F.lane;
                    const f32x4 wv = wv4[i], sc = *(const f32x4*)(mp + scale_off + col), sh = *(const f32x4*)(mp + shift_off + col);
#pragma unroll
                    for (int e = 0; e < 4; ++e) { h[i][e] = x[q][i][e] * rs * wv[e] * (1.f + sc[e]) + sh[e]; am = fmaxf(am, fabsf(h[i][e])); }
                    *(u32x2*)(H + (size_t)row * 1024 + col) = (u32x2){pk_bf16(h[i][0], h[i][1]), pk_bf16(h[i][2], h[i][3])}; }
                if (H8) {
#pragma unroll
                    for (int o = 32; o; o >>= 1) am = fmaxf(am, __shfl_xor(am, o));
                    const float s8 = am > 0.f ? 127.f / am : 1.f;
#pragma unroll
                    for (int i = 0; i < 4; ++i) *(unsigned*)(H8 + (size_t)row * 1024 + 256 * i + 4 * F.lane) = pack_i8x4(h[i], s8);
                    if (F.lane == 0) HS[row] = am > 0.f ? am * (1.f / 127.f) : 1.f;
                } } }
    }
}

__device__ __forceinline__ u32x4 conv_row8(const u32x4& xm, const u32x4& x0, const u32x4& x1, const f32x4 (&w0)[2], const f32x4 (&w1)[2], const f32x4 (&w2)[2], const f32x4 (&bb)[2]) {
    float o[8];
#pragma unroll
    for (int e = 0; e < 8; ++e) { const int dw = e >> 1, hh = e >> 2, q = e & 3;
        const float a = (e & 1) ? bf_hi(xm[dw]) : bf_lo(xm[dw]), b = (e & 1) ? bf_hi(x0[dw]) : bf_lo(x0[dw]), c = (e & 1) ? bf_hi(x1[dw]) : bf_lo(x1[dw]);
        o[e] = silu_f(bb[hh][q] + w0[hh][q] * a + w1[hh][q] * b + w2[hh][q] * c); }
    return (u32x4){pk_bf16(o[0], o[1]), pk_bf16(o[2], o[3]), pk_bf16(o[4], o[5]), pk_bf16(o[6], o[7])};
}
__device__ __forceinline__ void phase_conv(const Frame& F, const Params& p) {
    bf16_t* X = (bf16_t*)(p.ws + WS_XBC);
    const float* cw = p.in[12]; const float* cb = p.in[13];
    for (int task = F.bid * 512 + F.tid; task < 512 * 256; task += F.G * 512) {
        const int seg = task >> 8, col = (task & 255) * 8;
        bf16_t* base = X + (size_t)seg * 64 * 2048 + col;
        f32x4 w0[2], w1[2], w2[2], bb[2];
#pragma unroll
        for (int hh = 0; hh < 2; ++hh) { w0[hh] = *(const f32x4*)(cw + col + 4 * hh); w1[hh] = *(const f32x4*)(cw + 2048 + col + 4 * hh); w2[hh] = *(const f32x4*)(cw + 4096 + col + 4 * hh); bb[hh] = *(const f32x4*)(cb + col + 4 * hh); }
        u32x4 prev = {0u, 0u, 0u, 0u}, cur = *(const u32x4*)base;
#pragma unroll 1
        for (int r0 = 0; r0 < 64; r0 += 8) {
            u32x4 nx[8];
#pragma unroll
            for (int k = 0; k < 8; ++k) { nx[k] = (u32x4){0u, 0u, 0u, 0u}; if (r0 + k + 1 < 64) nx[k] = *(const u32x4*)(base + (size_t)(r0 + k + 1) * 2048); }
#pragma unroll
            for (int k = 0; k < 8; ++k) { const u32x4 o = conv_row8(prev, cur, nx[k], w0, w1, w2, bb); *(u32x4*)(base + (size_t)(r0 + k) * 2048) = o; prev = cur; cur = nx[k]; }
        }
    }
    for (int u = F.bid; u < 512; u += F.G) {
        const int row0 = ML + (u >> 6) * 256, col0 = (u & 63) * 32;
        const int vc = F.tid & 3, ra = 2 * (F.tid >> 2), col = col0 + 8 * vc;
        bf16_t* base = X + (size_t)row0 * 2048 + col;
        u32x4 L[4];
#pragma unroll
        for (int q = 0; q < 4; ++q) { const int lr = ra - 1 + q; L[q] = (u32x4){0u, 0u, 0u, 0u}; if (lr >= 0 && lr < 256) L[q] = *(const u32x4*)(base + (size_t)lr * 2048); }
        f32x4 w0[2], w1[2], w2[2], bb[2];
#pragma unroll
        for (int hh = 0; hh < 2; ++hh) { w0[hh] = *(const f32x4*)(cw + col + 4 * hh); w1[hh] = *(const f32x4*)(cw + 2048 + col + 4 * hh); w2[hh] = *(const f32x4*)(cw + 4096 + col + 4 * hh); bb[hh] = *(const f32x4*)(cb + col + 4 * hh); }
        const u32x4 va = conv_row8(L[0], L[1], L[2], w0, w1, w2, bb), vb = conv_row8(L[1], L[2], L[3], w0, w1, w2, bb);
        __syncthreads();
        *(u32x4*)(base + (size_t)ra * 2048) = va; *(u32x4*)(base + (size_t)(ra + 1) * 2048) = vb;
    }
}

typedef short s16x4 __attribute__((ext_vector_type(4)));
__device__ __forceinline__ bf16x8 ld_row(LAS unsigned char* lds, int base, int stride, int rt, int ks, int lane) {
    return *(const LAS bf16x8*)(lds + base + (16 * rt + (lane & 15)) * stride + (32 * ks + 8 * (lane >> 4)) * 2);
}
__device__ __forceinline__ bf16x8 ld_tr(LAS unsigned char* lds, int base, int stride, int ks, int c0, int lane) {
    const int a = base + (32 * ks + 8 * (lane >> 4) + ((lane & 15) >> 2)) * stride + (c0 + 4 * (lane & 3)) * 2;
    const s16x4 lo = __builtin_amdgcn_ds_read_tr16_b64_v4i16((LAS s16x4*)(lds + a));
    const s16x4 hi = __builtin_amdgcn_ds_read_tr16_b64_v4i16((LAS s16x4*)(lds + a + 4 * stride));
    return (bf16x8){lo[0], lo[1], lo[2], lo[3], hi[0], hi[1], hi[2], hi[3]};
}
template <int CTRL, int RMASK, bool BC> __device__ __forceinline__ float dpp_get(float v) { return __int_as_float(__builtin_amdgcn_update_dpp(0, __float_as_int(v), CTRL, RMASK, 0xf, BC)); }
__device__ __forceinline__ float wave_incl_scan(float v) {
    v += dpp_get<0x111, 0xf, true>(v); v += dpp_get<0x112, 0xf, true>(v); v += dpp_get<0x114, 0xf, true>(v); v += dpp_get<0x118, 0xf, true>(v);
    v += dpp_get<0x142, 0xa, false>(v); v += dpp_get<0x143, 0xc, false>(v);
    return v;
}
__device__ __forceinline__ int chunk_row0(int q, int b, int d) { if (q < 4) { const int c = d ? 3 - q : q; return ML + b * 256 + 64 * c; } const int c = d ? 67 - q : q - 4; return b * 4096 + 64 * c; }
__device__ __forceinline__ float softplus_f(float x) { return fmaxf(x, 0.f) + __logf(1.f + __expf(-fabsf(x))); }
__device__ __forceinline__ u16 dw_elem(const u32x4& v, int e) { return (u16)((e & 1) ? (v[e >> 1] >> 16) : (v[e >> 1] & 0xffffu)); }

constexpr int SS_STR = 288, SS_XSTR = 144;
constexpr int SS_CM = 0, SS_BM = 64 * SS_STR, SS_X = 2 * 64 * SS_STR, SS_XE = SS_X + 64 * SS_XSTR, SS_SET = SS_XE + 64 * SS_XSTR;
constexpr int SS_ST = 2 * SS_SET, SS_GM = SS_ST + 2 * 16384, SS_LA = SS_GM + 4 * 2048, SS_LDT = SS_LA + 2 * 256, SS_END = SS_LDT + 2 * 256;
static_assert(SS_END <= LDS_MISC, "SSD LDS map");
struct SsdRegs { u32x4 cm[2], bm[2], xv; float dtr; };
__device__ __forceinline__ void ssd_load(SsdRegs& R, const bf16_t* __restrict__ XBC, const float* __restrict__ DT, int r0, int g, int h, int d, int tid, int lane) {
    const int cs0 = tid >> 4, ck8 = tid & 15, xs = tid >> 3, xp8 = tid & 7; const bf16_t* rp = XBC + (size_t)r0 * 2048;
#pragma unroll
    for (int i = 0; i < 2; ++i) { R.cm[i] = *(const u32x4*)(rp + (size_t)(cs0 + 32 * i) * 2048 + 1536 + g * 128 + ck8 * 8); R.bm[i] = *(const u32x4*)(rp + (size_t)(cs0 + 32 * i) * 2048 + 1024 + g * 128 + ck8 * 8); }
    R.xv = *(const u32x4*)(rp + (size_t)xs * 2048 + h * 64 + xp8 * 8); R.dtr = DT[(size_t)(r0 + lane) * 32 + d * 16 + h];
}
__device__ __forceinline__ float ssd_stage(LAS unsigned char* lds, const SsdRegs& R, int set, int d, float a, float bias, int tid, int lane, int wave) {
    const int cs0 = tid >> 4, ck8 = tid & 15, xs = tid >> 3, xp8 = tid & 7; const int sb = set * SS_SET;
    const float dt = softplus_f(R.dtr + bias), lg = dt * a;
    float la;
    if (d == 0) la = wave_incl_scan(lg);
    else { const float rv = __shfl(lg, 63 - lane); la = __shfl(wave_incl_scan(rv), 63 - lane); }
    const float la_end = __shfl(la, d ? 0 : 63);
    const float ee = __expf(la_end - la) * dt;
    if (wave == 0) { *(LAS float*)(lds + SS_LA + set * 256 + lane * 4) = la; *(LAS float*)(lds + SS_LDT + set * 256 + lane * 4) = dt; }
#pragma unroll
    for (int i = 0; i < 2; ++i) { const int s = cs0 + 32 * i;
        *(LAS u32x4*)(lds + sb + SS_CM + s * SS_STR + ck8 * 16) = R.cm[i]; *(LAS u32x4*)(lds + sb + SS_BM + s * SS_STR + ck8 * 16) = R.bm[i]; }
    const float ees = __shfl(ee, xs);
    *(LAS u32x4*)(lds + sb + SS_X + xs * SS_XSTR + xp8 * 16) = R.xv;
    u32x4 xe;
#pragma unroll
    for (int i = 0; i < 4; ++i) xe[i] = pk_bf16(bf_lo(R.xv[i]) * ees, bf_hi(R.xv[i]) * ees);
    *(LAS u32x4*)(lds + sb + SS_XE + xs * SS_XSTR + xp8 * 16) = xe;
    return __expf(la_end);
}
__device__ __forceinline__ void ssd_compute(LAS unsigned char* lds, int set, int d, float dsk, float dec, f32x4 (&S)[4], int r0, int h, bf16_t* YL, bf16_t* YC, int lane, int wave) {
    const int sb = set * SS_SET, fr = lane & 15, fq = lane >> 4, tt = wave >> 1, ph = wave & 1;
    bf16x8 cmf[4], bmf[4][4];
#pragma unroll
    for (int ks = 0; ks < 4; ++ks) cmf[ks] = ld_row(lds, sb + SS_CM, SS_STR, tt, ks, lane);
#pragma unroll
    for (int si = 0; si < 4; ++si)
#pragma unroll
        for (int ks = 0; ks < 4; ++ks) bmf[si][ks] = ld_row(lds, sb + SS_BM, SS_STR, si, ks, lane);
    const int t = 16 * tt + fr; const float lat = *(LAS float*)(lds + SS_LA + set * 256 + t * 4);
    f32x4 las[4], dts[4];
#pragma unroll
    for (int si = 0; si < 4; ++si) { las[si] = *(LAS f32x4*)(lds + SS_LA + set * 256 + (16 * si + 4 * fq) * 4); dts[si] = *(LAS f32x4*)(lds + SS_LDT + set * 256 + (16 * si + 4 * fq) * 4); }
    __builtin_amdgcn_sched_barrier(0);
    f32x4 gacc[4] = {{0.f, 0.f, 0.f, 0.f}, {0.f, 0.f, 0.f, 0.f}, {0.f, 0.f, 0.f, 0.f}, {0.f, 0.f, 0.f, 0.f}};
#pragma unroll
    for (int ks = 0; ks < 4; ++ks)
#pragma unroll
        for (int si = 0; si < 4; ++si) gacc[si] = mfma16(bmf[si][ks], cmf[ks], gacc[si]);
    bf16x8 stf[2][4], btf[2], xef[4][2];
#pragma unroll
    for (int ps = 0; ps < 2; ++ps)
#pragma unroll
        for (int ks = 0; ks < 4; ++ks) stf[ps][ks] = ld_frag(lds, SS_ST + set * 16384, 2 * ph + ps, ks, 4, lane);
#pragma unroll
    for (int ks = 0; ks < 2; ++ks) { btf[ks] = ld_tr(lds, sb + SS_BM, SS_STR, ks, 16 * wave, lane);
#pragma unroll
        for (int pt = 0; pt < 4; ++pt) xef[pt][ks] = ld_tr(lds, sb + SS_XE, SS_XSTR, ks, 16 * pt, lane); }
    __builtin_amdgcn_sched_barrier(0);
#pragma unroll
    for (int si = 0; si < 4; ++si) { const int s0 = 16 * si + 4 * fq; float v[4];
#pragma unroll
        for (int j = 0; j < 4; ++j) { const int s = s0 + j; const bool ok = d ? (s >= t) : (s <= t); v[j] = ok ? gacc[si][j] * __expf(lat - las[si][j]) * dts[si][j] : 0.f; if (s == t) v[j] += dsk; }
        *(LAS u32x2*)(lds + SS_GM + tt * 2048 + frag_off(fr, s0 >> 3, 2) + (s0 & 7) * 2) = (u32x2){pk_bf16(v[0], v[1]), pk_bf16(v[2], v[3])}; }
    f32x4 y2[2] = {{0.f, 0.f, 0.f, 0.f}, {0.f, 0.f, 0.f, 0.f}};
#pragma unroll
    for (int pt = 0; pt < 4; ++pt) S[pt] *= dec;
    __builtin_amdgcn_sched_barrier(0);
#pragma unroll
    for (int ks = 0; ks < 4; ++ks)
#pragma unroll
        for (int ps = 0; ps < 2; ++ps) y2[ps] = mfma16(stf[ps][ks], cmf[ks], y2[ps]);
#pragma unroll
    for (int ks = 0; ks < 2; ++ks)
#pragma unroll
        for (int pt = 0; pt < 4; ++pt) S[pt] = mfma16(btf[ks], xef[pt][ks], S[pt]);
    bf16x8 gmf[2], xtf[2][2];
#pragma unroll
    for (int ks = 0; ks < 2; ++ks) { gmf[ks] = ld_frag(lds, SS_GM + tt * 2048, 0, ks, 2, lane);
#pragma unroll
        for (int ps = 0; ps < 2; ++ps) xtf[ps][ks] = ld_tr(lds, sb + SS_X, SS_XSTR, ks, 16 * (2 * ph + ps), lane); }
    __builtin_amdgcn_sched_barrier(0);
    f32x4 y1[2] = {{0.f, 0.f, 0.f, 0.f}, {0.f, 0.f, 0.f, 0.f}};
#pragma unroll
    for (int ks = 0; ks < 2; ++ks)
#pragma unroll
        for (int ps = 0; ps < 2; ++ps) y1[ps] = mfma16(xtf[ps][ks], gmf[ks], y1[ps]);
    { const float sc = __expf(lat);
      bf16_t* yp = ((r0 >= ML) ? YC + (size_t)(r0 - ML + t) * 1024 : YL + (size_t)(r0 + t) * 1024) + h * 64 + 32 * ph + 4 * fq;
#pragma unroll
      for (int ps = 0; ps < 2; ++ps) *(u32x2*)(yp + 16 * ps) = (u32x2){pk_bf16(y1[ps][0] + sc * y2[ps][0], y1[ps][1] + sc * y2[ps][1]), pk_bf16(y1[ps][2] + sc * y2[ps][2], y1[ps][3] + sc * y2[ps][3])}; }
    { const int n0 = 16 * wave + 4 * fq;
#pragma unroll
      for (int pt = 0; pt < 4; ++pt) *(LAS u32x2*)(lds + SS_ST + (set ^ 1) * 16384 + frag_off(16 * pt + fr, n0 >> 3, 4) + (n0 & 7) * 2) = (u32x2){pk_bf16(S[pt][0], S[pt][1]), pk_bf16(S[pt][2], S[pt][3])}; }
}
__device__ __forceinline__ void phase_ssd(const Frame& F, const Params& p) {
    LAS unsigned char* lds = F.lds;
    const bf16_t* XBC = (const bf16_t*)(p.ws + WS_XBC); const float* DT = (const float*)(p.ws + WS_DT);
    const int tid = F.tid, lane = F.lane, wave = F.wave, fr = lane & 15, fq = lane >> 4;
    const int tt = wave >> 1, ph = wave & 1;
    for (int u = F.bid; u < 256; u += F.G) {
        const int b = u >> 5, h = (u >> 1) & 15, d = u & 1, g = h >> 2;
        const float a = -__expf(p.in[15][d * 16 + h]), bias = p.in[14][d * 16 + h], dsk = d == 0 ? p.in[16][h] : 0.f;
        bf16_t* YL = (bf16_t*)((unsigned char*)p.out + (d ? DO_Y1 : 0)); bf16_t* YC = (bf16_t*)(p.ws + WS_YC) + (size_t)d * 2048 * 1024;
        for (int i = tid; i < 1024; i += 512) *(LAS u32x4*)(lds + SS_ST + i * 16) = (u32x4){0u, 0u, 0u, 0u};
        f32x4 S[4];
#pragma unroll
        for (int i = 0; i < 4; ++i) S[i] = (f32x4){0.f, 0.f, 0.f, 0.f};
        SsdRegs R;
        ssd_load(R, XBC, DT, chunk_row0(0, b, d), g, h, d, tid, lane);
        float dec_next = ssd_stage(lds, R, 0, d, a, bias, tid, lane, wave);
        ssd_load(R, XBC, DT, chunk_row0(1, b, d), g, h, d, tid, lane);
        __syncthreads();
        for (int q = 0; q < 68; ++q) {
            const int set = q & 1, sb = set * SS_SET, r0 = chunk_row0(q, b, d);
            const float dec = dec_next;
            if (q + 1 < 68) dec_next = ssd_stage(lds, R, set ^ 1, d, a, bias, tid, lane, wave);
            if (q + 2 < 68) ssd_load(R, XBC, DT, chunk_row0(q + 2, b, d), g, h, d, tid, lane);
            ssd_compute(lds, set, d, dsk, dec, S, r0, h, YL, YC, lane, wave);
            __syncthreads();
        }
    }
}

__device__ __forceinline__ void phase_finish0(const Frame& F, const Params& p, int row_first, int row_end, int row_stride) {
    const bf16_t* P4 = (const bf16_t*)(p.ws + WS_P4); bf16_t* A2 = (bf16_t*)(p.ws + WS_A2);
    const bf16_t* YL0 = (const bf16_t*)p.out; const bf16_t* YL1 = (const bf16_t*)((const unsigned char*)p.out + DO_Y1);
    const bf16_t* YC0 = (const bf16_t*)(p.ws + WS_YC); const bf16_t* YC1 = YC0 + (size_t)2048 * 1024;
    const int c0 = F.lane * 16;
    f32x4 w0[4], w1[4], w2[4], gn[4];
#pragma unroll
    for (int q = 0; q < 4; ++q) { w0[q] = *(const f32x4*)(p.in[11] + c0 + 4 * q); w1[q] = *(const f32x4*)(p.in[11] + 1024 + c0 + 4 * q); w2[q] = *(const f32x4*)(p.in[11] + 2048 + c0 + 4 * q); gn[q] = *(const f32x4*)(p.in[17] + c0 + 4 * q); }
    for (int row = row_first; row < row_end; row += row_stride) {
        bool hp, hn;
        if (row < ML) { const int lr = row & 63; hp = lr > 0; hn = lr < 63; } else { const int lr = (row - ML) & 255; hp = lr > 0; hn = lr < 255; }
        const bf16_t* pr = P4 + (size_t)row * 3072 + c0;
        u32x4 pc[2], pp[2], pn[2], sb[2], sz[2], y0[2], y1[2];
        const bf16_t* y0p = row < ML ? YL0 + (size_t)row * 1024 + c0 : YC0 + (size_t)(row - ML) * 1024 + c0;
        const bf16_t* y1p = row < ML ? YL1 + (size_t)row * 1024 + c0 : YC1 + (size_t)(row - ML) * 1024 + c0;
#pragma unroll
        for (int i = 0; i < 2; ++i) { pc[i] = *(const u32x4*)(pr + 8 * i); sb[i] = *(const u32x4*)(pr + 1024 + 8 * i); sz[i] = *(const u32x4*)(pr + 2048 + 8 * i);
            pp[i] = (u32x4){0u, 0u, 0u, 0u}; pn[i] = (u32x4){0u, 0u, 0u, 0u};
            if (hp) pp[i] = *(const u32x4*)(pr - 3072 + 8 * i);
            if (hn) pn[i] = *(const u32x4*)(pr + 3072 + 8 * i);
            y0[i] = *(const u32x4*)(y0p + 8 * i); y1[i] = *(const u32x4*)(y1p + 8 * i); }
        float ya[16], yb[16]; float ss = 0.f;
#pragma unroll
        for (int i = 0; i < 2; ++i)
#pragma unroll
            for (int q = 0; q < 2; ++q) { const int wq = 2 * i + q;
#pragma unroll
                for (int e = 0; e < 4; ++e) { const int dw = 2 * q + (e >> 1), o = 8 * i + 4 * q + e;
                    const float xp = (e & 1) ? bf_hi(pp[i][dw]) : bf_lo(pp[i][dw]), xc = (e & 1) ? bf_hi(pc[i][dw]) : bf_lo(pc[i][dw]), xn = (e & 1) ? bf_hi(pn[i][dw]) : bf_lo(pn[i][dw]);
                    const float bv = (e & 1) ? bf_hi(sb[i][dw]) : bf_lo(sb[i][dw]), zv = (e & 1) ? bf_hi(sz[i][dw]) : bf_lo(sz[i][dw]);
                    const float ya0 = (e & 1) ? bf_hi(y0[i][dw]) : bf_lo(y0[i][dw]), ya1 = (e & 1) ? bf_hi(y1[i][dw]) : bf_lo(y1[i][dw]);
                    ya[o] = bv * (w0[wq][e] * xp + w1[wq][e] * xc + w2[wq][e] * xn);
                    const float v = (ya0 + ya1) * zv; yb[o] = v; ss += v * v; } }
        ss += __shfl_xor(ss, 1); ss += __shfl_xor(ss, 2); ss += __shfl_xor(ss, 4); ss += __shfl_xor(ss, 8);
        const float rs = rsqrtf(ss * (1.f / 256.f) + NORM_EPS);
        bf16_t* ap = A2 + (size_t)row * 2048 + c0;
#pragma unroll
        for (int i = 0; i < 2; ++i) {
            const f32x4 g0 = gn[2 * i], g1 = gn[2 * i + 1];
            *(u32x4*)(ap + 8 * i) = (u32x4){pk_bf16(ya[8 * i], ya[8 * i + 1]), pk_bf16(ya[8 * i + 2], ya[8 * i + 3]), pk_bf16(ya[8 * i + 4], ya[8 * i + 5]), pk_bf16(ya[8 * i + 6], ya[8 * i + 7])};
            *(u32x4*)(ap + 1024 + 8 * i) = (u32x4){pk_bf16(yb[8 * i] * rs * g0[0], yb[8 * i + 1] * rs * g0[1]), pk_bf16(yb[8 * i + 2] * rs * g0[2], yb[8 * i + 3] * rs * g0[3]),
                                                   pk_bf16(yb[8 * i + 4] * rs * g1[0], yb[8 * i + 5] * rs * g1[1]), pk_bf16(yb[8 * i + 6] * rs * g1[2], yb[8 * i + 7] * rs * g1[3])}; }
    }
}

__device__ __forceinline__ int enc_key(float s) { const int b = __float_as_int(s); return b ^ ((b >> 31) & 0x7fffffff); }
__device__ __forceinline__ float dec_key(int k) { return __int_as_float(k ^ ((k >> 31) & 0x7fffffff)); }
__device__ __forceinline__ int med3i(int a, int b, int c) { return max(min(a, b), min(max(a, b), c)); }
#define TK_INSERT(L, v) do { _Pragma("unroll") for (int _i = 15; _i > 0; --_i) L[_i] = med3i(L[_i - 1], L[_i], (v)); L[0] = max(L[0], (v)); } while (0)
__device__ __forceinline__ void tk_merge(int (&L)[16], int xr) {
    int P[16];
#pragma unroll
    for (int i = 0; i < 16; ++i) P[i] = __shfl_xor(L[i], xr);
#pragma unroll
    for (int i = 0; i < 16; ++i) L[i] = max(L[i], P[15 - i]);
#pragma unroll
    for (int st = 8; st > 0; st >>= 1)
#pragma unroll
        for (int i = 0; i < 16; ++i) if ((i & st) == 0) { const int a = L[i], b = L[i + st]; L[i] = max(a, b); L[i + st] = min(a, b); }
}
__device__ __forceinline__ void tk_top16(int (&L)[16], const int (&P)[16]) {
#pragma unroll
    for (int i = 0; i < 16; ++i) L[i] = max(L[i], P[15 - i]);
#pragma unroll
    for (int st = 8; st > 0; st >>= 1)
#pragma unroll
        for (int i = 0; i < 16; ++i) if ((i & st) == 0) { const int a = L[i], b = L[i + st]; L[i] = max(a, b); L[i + st] = min(a, b); }
}
constexpr int TK_Q = 0, TK_K = 65536;
#define TK_CE(L, i, j) do { const int _a = L[i], _b = L[j]; L[i] = max(_a, _b); L[j] = min(_a, _b); } while (0)
__device__ __forceinline__ void topk_half(LAS unsigned char* lds, int a, const u32x4 (&qf)[8], int lane, int (&L)[16]) {
    const int fq = lane >> 4;
    int M[16];
    bf16x8 bq[4];
#pragma unroll
    for (int ks = 0; ks < 4; ++ks) bq[ks] = __builtin_bit_cast(bf16x8, qf[a * 4 + ks]);
#pragma unroll
    for (int nh = 0; nh < 4; ++nh) {
        bf16x8 kf[2][4];
#pragma unroll
        for (int n = 0; n < 2; ++n)
#pragma unroll
            for (int ks = 0; ks < 4; ++ks) kf[n][ks] = ld_frag(lds, TK_K, a * 8 + 2 * nh + n, ks, 4, lane);
        __builtin_amdgcn_sched_barrier(0);
        f32x4 acc[2] = {{0.f, 0.f, 0.f, 0.f}, {0.f, 0.f, 0.f, 0.f}};
#pragma unroll
        for (int ks = 0; ks < 4; ++ks)
#pragma unroll
            for (int n = 0; n < 2; ++n) acc[n] = mfma16(kf[n][ks], bq[ks], acc[n]);
        __builtin_amdgcn_sched_barrier(0);
#pragma unroll
        for (int n = 0; n < 2; ++n)
#pragma unroll
            for (int j = 0; j < 4; ++j) { const int key = (enc_key(acc[n][j]) & ~127) | (16 * (2 * nh + n) + 4 * fq + j); if (nh < 2) L[8 * nh + 4 * n + j] = key; else M[8 * (nh - 2) + 4 * n + j] = key; }
        if (nh == 1) { TK_CE(L, 0, 1); TK_CE(L, 2, 3); TK_CE(L, 0, 2); TK_CE(L, 1, 3); TK_CE(L, 1, 2); TK_CE(L, 4, 5); TK_CE(L, 6, 7); TK_CE(L, 4, 6); TK_CE(L, 5, 7); TK_CE(L, 5, 6); TK_CE(L, 0, 4); TK_CE(L, 2, 6); TK_CE(L, 2, 4); TK_CE(L, 1, 5); TK_CE(L, 3, 7); TK_CE(L, 3, 5); TK_CE(L, 1, 2); TK_CE(L, 3, 4); TK_CE(L, 5, 6); TK_CE(L, 8, 9); TK_CE(L, 10, 11); TK_CE(L, 8, 10); TK_CE(L, 9, 11); TK_CE(L, 9, 10); TK_CE(L, 12, 13); TK_CE(L, 14, 15); TK_CE(L, 12, 14); TK_CE(L, 13, 15); TK_CE(L, 13, 14); TK_CE(L, 8, 12); TK_CE(L, 10, 14); TK_CE(L, 10, 12); TK_CE(L, 9, 13); TK_CE(L, 11, 15); TK_CE(L, 11, 13); TK_CE(L, 9, 10); TK_CE(L, 11, 12); TK_CE(L, 13, 14); TK_CE(L, 0, 8); TK_CE(L, 4, 12); TK_CE(L, 4, 8); TK_CE(L, 2, 10); TK_CE(L, 6, 14); TK_CE(L, 6, 10); TK_CE(L, 2, 4); TK_CE(L, 6, 8); TK_CE(L, 10, 12); TK_CE(L, 1, 9); TK_CE(L, 5, 13); TK_CE(L, 5, 9); TK_CE(L, 3, 11); TK_CE(L, 7, 15); TK_CE(L, 7, 11); TK_CE(L, 3, 5); TK_CE(L, 7, 9); TK_CE(L, 11, 13); TK_CE(L, 1, 2); TK_CE(L, 3, 4); TK_CE(L, 5, 6); TK_CE(L, 7, 8); TK_CE(L, 9, 10); TK_CE(L, 11, 12); TK_CE(L, 13, 14); }
        if (nh == 3) { TK_CE(M, 0, 1); TK_CE(M, 2, 3); TK_CE(M, 0, 2); TK_CE(M, 1, 3); TK_CE(M, 1, 2); TK_CE(M, 4, 5); TK_CE(M, 6, 7); TK_CE(M, 4, 6); TK_CE(M, 5, 7); TK_CE(M, 5, 6); TK_CE(M, 0, 4); TK_CE(M, 2, 6); TK_CE(M, 2, 4); TK_CE(M, 1, 5); TK_CE(M, 3, 7); TK_CE(M, 3, 5); TK_CE(M, 1, 2); TK_CE(M, 3, 4); TK_CE(M, 5, 6); TK_CE(M, 8, 9); TK_CE(M, 10, 11); TK_CE(M, 8, 10); TK_CE(M, 9, 11); TK_CE(M, 9, 10); TK_CE(M, 12, 13); TK_CE(M, 14, 15); TK_CE(M, 12, 14); TK_CE(M, 13, 15); TK_CE(M, 13, 14); TK_CE(M, 8, 12); TK_CE(M, 10, 14); TK_CE(M, 10, 12); TK_CE(M, 9, 13); TK_CE(M, 11, 15); TK_CE(M, 11, 13); TK_CE(M, 9, 10); TK_CE(M, 11, 12); TK_CE(M, 13, 14); TK_CE(M, 0, 8); TK_CE(M, 4, 12); TK_CE(M, 4, 8); TK_CE(M, 2, 10); TK_CE(M, 6, 14); TK_CE(M, 6, 10); TK_CE(M, 2, 4); TK_CE(M, 6, 8); TK_CE(M, 10, 12); TK_CE(M, 1, 9); TK_CE(M, 5, 13); TK_CE(M, 5, 9); TK_CE(M, 3, 11); TK_CE(M, 7, 15); TK_CE(M, 7, 11); TK_CE(M, 3, 5); TK_CE(M, 7, 9); TK_CE(M, 11, 13); TK_CE(M, 1, 2); TK_CE(M, 3, 4); TK_CE(M, 5, 6); TK_CE(M, 7, 8); TK_CE(M, 9, 10); TK_CE(M, 11, 12); TK_CE(M, 13, 14); }
    }
    tk_top16(L, M);
    tk_merge(L, 16); tk_merge(L, 32);
}
__device__ __forceinline__ unsigned tk_lookup(const unsigned (&P)[4], int i) {
    const int q = i >> 2; const unsigned dwv = q == 0 ? P[0] : (q == 1 ? P[1] : (q == 2 ? P[2] : P[3]));
    return (dwv >> ((i & 3) * 8)) & 127u;
}
__device__ __forceinline__ void phase_topk(const Frame& F, const Params& p, int layer, const bf16_t* __restrict__ Q, int M, u16* __restrict__ IDX, float* __restrict__ GATE, float* __restrict__ SUA) {
    LAS unsigned char* lds = F.lds;
    const float* SCU = (const float*)(p.ws + WS_TAB + TAB_SCU); const float* SCV = (const float*)(p.ws + WS_TAB + TAB_SCV);
    const bf16_t* KEYS = (const bf16_t*)(p.ws + WS_KEYS) + (size_t)layer * 8 * 2 * 128 * 128;
    const int tid = F.tid, lane = F.lane, wave = F.wave, fr = lane & 15, fq = lane >> 4;
    const int nunits = (M >> 7) * 8;
    int head_staged = -1;
    float pend_su[4], pend_sv[4], pend_gt[4]; size_t pend_o = 0; bool pend_valid = false;
#pragma unroll
    for (int kk = 0; kk < 4; ++kk) { pend_su[kk] = 0.f; pend_sv[kk] = 0.f; pend_gt[kk] = 0.f; }
    u32x4 qpre[8];
    if (F.bid < nunits) {
#pragma unroll
        for (int ks = 0; ks < 8; ++ks) qpre[ks] = *(const u32x4*)(Q + (size_t)((F.bid >> 3) * 128 + 16 * wave + fr) * 2048 + (F.bid & 7) * 256 + 32 * ks + 8 * fq);
    }
    for (int u = F.bid; u < nunits; u += F.G) {
        const int head = u & 7, row0 = (u >> 3) * 128;
        if (head != head_staged) {
            __syncthreads();
#pragma unroll
            for (int i = 0; i < 8; ++i) { const int o = tid + 512 * i, r = o >> 4, k8 = o & 15;
                *(LAS u32x4*)(lds + TK_K + frag_off(r, k8, 4)) = *(const u32x4*)(KEYS + (size_t)(head * 256 + r) * 128 + k8 * 8); }
            head_staged = head;
            __syncthreads();
        }
        u32x4 qf[8];
#pragma unroll
        for (int ks = 0; ks < 8; ++ks) qf[ks] = qpre[ks];
        { const int un = u + F.G;
          if (un < nunits) {
#pragma unroll
              for (int ks = 0; ks < 8; ++ks) qpre[ks] = *(const u32x4*)(Q + (size_t)((un >> 3) * 128 + 16 * wave + fr) * 2048 + (un & 7) * 256 + 32 * ks + 8 * fq); } }
        int L0[16], L1[16];
        topk_half(lds, 0, qf, lane, L0);
        topk_half(lds, 1, qf, lane, L1);
        float f0[16], f1[16];
#pragma unroll
        for (int i = 0; i < 16; ++i) { f0[i] = dec_key(L0[i] & ~127); f1[i] = dec_key(L1[i] & ~127); }
        int C[16];
#pragma unroll
        for (int i = 0; i < 16; ++i) C[i] = (int)0x80000000;
        { const float sv = fq == 0 ? (f0[0] + f1[0]) : (fq == 1 ? (f0[0] + f1[1]) : (fq == 2 ? (f0[0] + f1[2]) : (f0[0] + f1[3]))); const int pay = fq == 0 ? 0 : (fq == 1 ? 1 : (fq == 2 ? 2 : 3)); C[0] = (enc_key(sv) & ~255) | pay; }
        { const float sv = fq == 0 ? (f0[0] + f1[4]) : (fq == 1 ? (f0[0] + f1[5]) : (fq == 2 ? (f0[0] + f1[6]) : (f0[0] + f1[7]))); const int pay = fq == 0 ? 4 : (fq == 1 ? 5 : (fq == 2 ? 6 : 7)); C[1] = (enc_key(sv) & ~255) | pay; }
        { const float sv = fq == 0 ? (f0[0] + f1[8]) : (fq == 1 ? (f0[0] + f1[9]) : (fq == 2 ? (f0[0] + f1[10]) : (f0[0] + f1[11]))); const int pay = fq == 0 ? 8 : (fq == 1 ? 9 : (fq == 2 ? 10 : 11)); C[2] = (enc_key(sv) & ~255) | pay; }
        { const float sv = fq == 0 ? (f0[0] + f1[12]) : (fq == 1 ? (f0[0] + f1[13]) : (fq == 2 ? (f0[0] + f1[14]) : (f0[0] + f1[15]))); const int pay = fq == 0 ? 12 : (fq == 1 ? 13 : (fq == 2 ? 14 : 15)); C[3] = (enc_key(sv) & ~255) | pay; }
        { const float sv = fq == 0 ? (f0[1] + f1[0]) : (fq == 1 ? (f0[1] + f1[1]) : (fq == 2 ? (f0[1] + f1[2]) : (f0[1] + f1[3]))); const int pay = fq == 0 ? 16 : (fq == 1 ? 17 : (fq == 2 ? 18 : 19)); C[4] = (enc_key(sv) & ~255) | pay; }
        { const float sv = fq == 0 ? (f0[1] + f1[4]) : (fq == 1 ? (f0[1] + f1[5]) : (fq == 2 ? (f0[1] + f1[6]) : (f0[1] + f1[7]))); const int pay = fq == 0 ? 20 : (fq == 1 ? 21 : (fq == 2 ? 22 : 23)); C[5] = (enc_key(sv) & ~255) | pay; }
        { const float sv = fq == 0 ? (f0[2] + f1[0]) : (fq == 1 ? (f0[2] + f1[1]) : (fq == 2 ? (f0[2] + f1[2]) : (f0[2] + f1[3]))); const int pay = fq == 0 ? 32 : (fq == 1 ? 33 : (fq == 2 ? 34 : 35)); C[6] = (enc_key(sv) & ~255) | pay; }
        { const float sv = fq == 0 ? (f0[2] + f1[4]) : (fq == 1 ? (f0[3] + f1[0]) : (fq == 2 ? (f0[3] + f1[1]) : (f0[3] + f1[2]))); const int pay = fq == 0 ? 36 : (fq == 1 ? 48 : (fq == 2 ? 49 : 50)); C[7] = (enc_key(sv) & ~255) | pay; }
        { const float sv = fq == 0 ? (f0[3] + f1[3]) : (fq == 1 ? (f0[4] + f1[0]) : (fq == 2 ? (f0[4] + f1[1]) : (f0[4] + f1[2]))); const int pay = fq == 0 ? 51 : (fq == 1 ? 64 : (fq == 2 ? 65 : 66)); C[8] = (enc_key(sv) & ~255) | pay; }
        { const float sv = fq == 0 ? (f0[5] + f1[0]) : (fq == 1 ? (f0[5] + f1[1]) : (fq == 2 ? (f0[6] + f1[0]) : (f0[6] + f1[1]))); const int pay = fq == 0 ? 80 : (fq == 1 ? 81 : (fq == 2 ? 96 : 97)); C[9] = (enc_key(sv) & ~255) | pay; }
        { const float sv = fq == 0 ? (f0[7] + f1[0]) : (fq == 1 ? (f0[7] + f1[1]) : (fq == 2 ? (f0[8] + f1[0]) : (f0[9] + f1[0]))); const int pay = fq == 0 ? 112 : (fq == 1 ? 113 : (fq == 2 ? 128 : 144)); C[10] = (enc_key(sv) & ~255) | pay; }
        { const float sv = fq == 0 ? (f0[10] + f1[0]) : (fq == 1 ? (f0[11] + f1[0]) : (fq == 2 ? (f0[12] + f1[0]) : (f0[13] + f1[0]))); const int pay = fq == 0 ? 160 : (fq == 1 ? 176 : (fq == 2 ? 192 : 208)); C[11] = (enc_key(sv) & ~255) | pay; }
        { const float sv = fq == 0 ? (f0[14] + f1[0]) : (fq == 1 ? (f0[15] + f1[0]) : (fq == 2 ? (-3.0e38f) : (-3.0e38f))); const int pay = fq == 0 ? 224 : (fq == 1 ? 240 : (fq == 2 ? 0 : 0)); C[12] = (enc_key(sv) & ~255) | pay; }
        { TK_CE(C, 0, 1); TK_CE(C, 2, 3); TK_CE(C, 0, 2); TK_CE(C, 1, 3); TK_CE(C, 1, 2); TK_CE(C, 4, 5); TK_CE(C, 6, 7); TK_CE(C, 4, 6); TK_CE(C, 5, 7); TK_CE(C, 5, 6); TK_CE(C, 0, 4); TK_CE(C, 2, 6); TK_CE(C, 2, 4); TK_CE(C, 1, 5); TK_CE(C, 3, 7); TK_CE(C, 3, 5); TK_CE(C, 1, 2); TK_CE(C, 3, 4); TK_CE(C, 5, 6); TK_CE(C, 8, 9); TK_CE(C, 10, 11); TK_CE(C, 8, 10); TK_CE(C, 9, 11); TK_CE(C, 9, 10); TK_CE(C, 12, 13); TK_CE(C, 14, 15); TK_CE(C, 12, 14); TK_CE(C, 13, 15); TK_CE(C, 13, 14); TK_CE(C, 8, 12); TK_CE(C, 10, 14); TK_CE(C, 10, 12); TK_CE(C, 9, 13); TK_CE(C, 11, 15); TK_CE(C, 11, 13); TK_CE(C, 9, 10); TK_CE(C, 11, 12); TK_CE(C, 13, 14); TK_CE(C, 0, 8); TK_CE(C, 4, 12); TK_CE(C, 4, 8); TK_CE(C, 2, 10); TK_CE(C, 6, 14); TK_CE(C, 6, 10); TK_CE(C, 2, 4); TK_CE(C, 6, 8); TK_CE(C, 10, 12); TK_CE(C, 1, 9); TK_CE(C, 5, 13); TK_CE(C, 5, 9); TK_CE(C, 3, 11); TK_CE(C, 7, 15); TK_CE(C, 7, 11); TK_CE(C, 3, 5); TK_CE(C, 7, 9); TK_CE(C, 11, 13); TK_CE(C, 1, 2); TK_CE(C, 3, 4); TK_CE(C, 5, 6); TK_CE(C, 7, 8); TK_CE(C, 9, 10); TK_CE(C, 11, 12); TK_CE(C, 13, 14); }
        tk_merge(C, 16); tk_merge(C, 32);
        unsigned P0[4], P1[4];
#pragma unroll
        for (int q = 0; q < 4; ++q) { P0[q] = (unsigned)(L0[4 * q] & 127) | ((unsigned)(L0[4 * q + 1] & 127) << 8) | ((unsigned)(L0[4 * q + 2] & 127) << 16) | ((unsigned)(L0[4 * q + 3] & 127) << 24);
                                      P1[q] = (unsigned)(L1[4 * q] & 127) | ((unsigned)(L1[4 * q + 1] & 127) << 8) | ((unsigned)(L1[4 * q + 2] & 127) << 16) | ((unsigned)(L1[4 * q + 3] & 127) << 24); }
        const float mx = dec_key(C[0] & ~255);
        float sum = 0.f;
#pragma unroll
        for (int k = 0; k < 16; ++k) sum += __expf(dec_key(C[k] & ~255) - mx);
        const float inv = 1.f / sum;
        unsigned eidx[4]; float gt[4];
#pragma unroll
        for (int kk = 0; kk < 4; ++kk) { const int ck = fq == 0 ? C[kk] : (fq == 1 ? C[4 + kk] : (fq == 2 ? C[8 + kk] : C[12 + kk]));
            gt[kk] = __expf(dec_key(ck & ~255) - mx) * inv; const int pos = ck & 255; eidx[kk] = tk_lookup(P0, pos >> 4) * 128u + tk_lookup(P1, pos & 15); }
        if (pend_valid) { const size_t o = pend_o;
            *(f32x4*)(GATE + o) = (f32x4){pend_gt[0] * pend_sv[0], pend_gt[1] * pend_sv[1], pend_gt[2] * pend_sv[2], pend_gt[3] * pend_sv[3]};
            *(f32x4*)(SUA + o) = (f32x4){pend_su[0], pend_su[1], pend_su[2], pend_su[3]}; }
        { const size_t o = (size_t)(row0 + 16 * wave + fr) * 128 + head * 16 + 4 * fq;
          *(u32x2*)(IDX + o) = (u32x2){eidx[0] | (eidx[1] << 16), eidx[2] | (eidx[3] << 16)};
#pragma unroll
          for (int kk = 0; kk < 4; ++kk) { pend_su[kk] = SCU[eidx[kk]]; pend_sv[kk] = SCV[eidx[kk]]; pend_gt[kk] = gt[kk]; }
          pend_o = o; pend_valid = true; }
    }
    if (pend_valid) { const size_t o = pend_o;
        *(f32x4*)(GATE + o) = (f32x4){pend_gt[0] * pend_sv[0], pend_gt[1] * pend_sv[1], pend_gt[2] * pend_sv[2], pend_gt[3] * pend_sv[3]};
        *(f32x4*)(SUA + o) = (f32x4){pend_su[0], pend_su[1], pend_su[2], pend_su[3]}; }
    __syncthreads();
}

constexpr size_t WS_QUEUE = 16384;
__device__ __forceinline__ int q_next(const Frame& F, unsigned* head, int pending_valid, int& pending) {
    volatile LAS int* w = (volatile LAS int*)(F.lds + LDS_MISC + 64);
    if (F.tid == 0) { *w = pending_valid ? pending : (int)__hip_atomic_fetch_add(head, 1u, __ATOMIC_RELAXED, __HIP_MEMORY_SCOPE_AGENT); }
    __syncthreads();
    const int v = *w;
    __syncthreads();
    if (F.tid == 0) pending = (int)__hip_atomic_fetch_add(head, 1u, __ATOMIC_RELAXED, __HIP_MEMORY_SCOPE_AGENT);
    return v;
}
constexpr int PEER_TOK = 8;
__device__ __forceinline__ void g1_issue(u32x4 (&uu)[16], int id0, int id1, const unsigned char* __restrict__ Ux, int g) {
#pragma unroll
    for (int L = 0; L < 16; ++L) { const int eid = __shfl(L < 8 ? id0 : id1, (8 * L + g) & 63); uu[L] = *(const u32x4*)(Ux + (size_t)eid * 128); }
}
__device__ __forceinline__ void g1i_compute(const u32x4 (&uu)[16], const u32x4& hq, int c, bf16_t* __restrict__ dst) {
    int pv[16];
#pragma unroll
    for (int L = 0; L < 16; ++L) { int a = 0;
#pragma unroll
        for (int i = 0; i < 4; ++i) a = __builtin_amdgcn_sdot4((int)uu[L][i], (int)hq[i], a, false);
        pv[L] = a; }
    int r8[8], r4[4], r2[2];
    { const bool hi = (c & 1) != 0;
#pragma unroll
      for (int i = 0; i < 8; ++i) { const int send = hi ? pv[i] : pv[8 + i], keep = hi ? pv[8 + i] : pv[i]; r8[i] = keep + __shfl_xor(send, 1); } }
    { const bool hi = (c & 2) != 0;
#pragma unroll
      for (int i = 0; i < 4; ++i) { const int send = hi ? r8[i] : r8[4 + i], keep = hi ? r8[4 + i] : r8[i]; r4[i] = keep + __shfl_xor(send, 2); } }
    { const bool hi = (c & 4) != 0;
#pragma unroll
      for (int i = 0; i < 2; ++i) { const int send = hi ? r4[i] : r4[2 + i], keep = hi ? r4[2 + i] : r4[i]; r2[i] = keep + __shfl_xor(send, 4); } }
    __builtin_nontemporal_store(pk_bf16((float)r2[0], (float)r2[1]), (unsigned*)dst);
}
__device__ __forceinline__ void phase_peer_g1i(const Frame& F, const Params& p, const unsigned char* __restrict__ H8, const u16* __restrict__ IDX, bf16_t* PART, int M, int qslot) {
    const unsigned char* U8 = p.ws + WS_TAB;
    unsigned* heads = (unsigned*)(p.ws + WS_CTL + WS_QUEUE) + (size_t)qslot * 8 * 64;
    const int nitems = M / (8 * PEER_TOK), myx = (int)(xb_xcc_id() & 7u), lane = F.lane, g = lane >> 3, c = lane & 7;
    for (int k = 0; k < 8; ++k) { const int x = (myx + k) & 7; bf16_t* PARTx = PART + (size_t)x * M * 128;
        const unsigned char* Ux = U8 + (size_t)x * TAB_SLICE + 16 * c; int pending = 0, pv = 0;
        for (;;) { const int item = q_next(F, heads + x * 64, pv, pending); pv = 1; if (item >= nitems) break;
            const int t0 = item * 8 * PEER_TOK + F.wave;
            int id0[2], id1[2]; u32x4 hq[2], uu[2][16];
#pragma unroll
            for (int r = 0; r < 2; ++r) { const size_t t = (size_t)(t0 + 8 * r); id0[r] = IDX[t * 128 + lane]; id1[r] = IDX[t * 128 + 64 + lane];
                hq[r] = *(const u32x4*)(H8 + t * 1024 + 128 * x + 16 * c); }
            g1_issue(uu[0], id0[0], id1[0], Ux, g);
#pragma unroll
            for (int r = 0; r < PEER_TOK; ++r) { const int cur = r & 1;
                if (r + 1 < PEER_TOK) g1_issue(uu[cur ^ 1], id0[cur ^ 1], id1[cur ^ 1], Ux, g);
                const u32x4 hc = hq[cur];
                if (r + 2 < PEER_TOK) { const size_t t = (size_t)(t0 + 8 * (r + 2)); id0[cur] = IDX[t * 128 + lane]; id1[cur] = IDX[t * 128 + 64 + lane];
                    hq[cur] = *(const u32x4*)(H8 + t * 1024 + 128 * x + 16 * c); }
                g1i_compute(uu[cur], hc, c, PARTx + (size_t)(t0 + 8 * r) * 128 + 2 * lane); } } }
}
__device__ __forceinline__ void phase_peer_g2(const Frame& F, const Params& p, const float* __restrict__ SUA, const float* __restrict__ GATE, const float* __restrict__ HS, const bf16_t* __restrict__ PART, unsigned char* __restrict__ ACT, int M) {
    const int lane = F.lane, g = lane >> 3, c = lane & 7, L0 = 8 * (c & 1) + 4 * ((c >> 1) & 1) + 2 * ((c >> 2) & 1);
    float* SA = (float*)(ACT + ACT_SA);
    const int stride = F.G * 8;
    for (int t0 = F.bid * 8 + F.wave; t0 < M; t0 += 2 * stride) {
        f32x2 s[2]; float hs[2], su[2][2], gt[2][2];
#pragma unroll
        for (int q = 0; q < 2; ++q) { const int t = t0 + q * stride; s[q] = (f32x2){0.f, 0.f};
            if (t < M) {
#pragma unroll
                for (int x = 0; x < 8; ++x) { const unsigned pv2 = *(const unsigned*)(PART + ((size_t)x * M + t) * 128 + 2 * lane); s[q] += (f32x2){bf_lo(pv2), bf_hi(pv2)}; }
                hs[q] = HS[t];
#pragma unroll
                for (int j = 0; j < 2; ++j) { const int k = 8 * (L0 + j) + g; su[q][j] = SUA[(size_t)t * 128 + k]; gt[q][j] = GATE[(size_t)t * 128 + k]; } } }
#pragma unroll
        for (int q = 0; q < 2; ++q) { const int t = t0 + q * stride;
            if (t < M) {
                float a[2];
#pragma unroll
                for (int j = 0; j < 2; ++j) { const float dv = s[q][j] * su[q][j] * hs[q]; a[j] = gt[q][j] * 0.5f * dv * (1.f + erff(dv * 0.70710678118654752f)); }
                float am = fmaxf(fabsf(a[0]), fabsf(a[1]));
#pragma unroll
                for (int o = 32; o; o >>= 1) am = fmaxf(am, __shfl_xor(am, o));
                const float sc = am > 0.f ? 127.f / am : 1.f;
                const int q0 = max(-127, min(127, __float2int_rn(a[0] * sc))), q1 = max(-127, min(127, __float2int_rn(a[1] * sc)));
                *(u16*)(ACT + (size_t)t * 128 + g * 16 + L0) = (u16)(((unsigned)q0 & 0xffu) | (((unsigned)q1 & 0xffu) << 8));
                if (lane == 0) SA[t] = am > 0.f ? am * (1.f / 127.f) : 0.f; } }
    }
}
struct G3Pre { int id0, id1; u32x4 aq; float sa; };
__device__ __forceinline__ void g3i_compute(const u32x4 (&vv)[16], const u32x4& aq, float sa, int g, bf16_t* op) {
    int ov[16];
#pragma unroll
    for (int i = 0; i < 4; ++i) {
        int acc[4] = {0, 0, 0, 0};
#pragma unroll
        for (int q = 0; q < 4; ++q) {
            const unsigned r0 = vv[4 * q][i], r1 = vv[4 * q + 1][i], r2 = vv[4 * q + 2][i], r3 = vv[4 * q + 3][i];
            const unsigned t0 = __builtin_amdgcn_perm(r1, r0, 0x05010400u), t1 = __builtin_amdgcn_perm(r1, r0, 0x07030602u);
            const unsigned t2 = __builtin_amdgcn_perm(r3, r2, 0x05010400u), t3 = __builtin_amdgcn_perm(r3, r2, 0x07030602u);
            const unsigned o0 = __builtin_amdgcn_perm(t2, t0, 0x05040100u), o1 = __builtin_amdgcn_perm(t2, t0, 0x07060302u);
            const unsigned o2 = __builtin_amdgcn_perm(t3, t1, 0x05040100u), o3 = __builtin_amdgcn_perm(t3, t1, 0x07060302u);
            acc[0] = __builtin_amdgcn_sdot4((int)o0, (int)aq[q], acc[0], false); acc[1] = __builtin_amdgcn_sdot4((int)o1, (int)aq[q], acc[1], false);
            acc[2] = __builtin_amdgcn_sdot4((int)o2, (int)aq[q], acc[2], false); acc[3] = __builtin_amdgcn_sdot4((int)o3, (int)aq[q], acc[3], false); }
        ov[4 * i] = acc[0]; ov[4 * i + 1] = acc[1]; ov[4 * i + 2] = acc[2]; ov[4 * i + 3] = acc[3]; }
    int r8[8], r4[4], r2[2];
    { const bool hi = (g & 1) != 0;
#pragma unroll
      for (int i = 0; i < 8; ++i) { const int send = hi ? ov[i] : ov[8 + i], keep = hi ? ov[8 + i] : ov[i]; r8[i] = keep + __shfl_xor(send, 8); } }
    { const bool hi = (g & 2) != 0;
#pragma unroll
      for (int i = 0; i < 4; ++i) { const int send = hi ? r8[i] : r8[4 + i], keep = hi ? r8[4 + i] : r8[i]; r4[i] = keep + __shfl_xor(send, 16); } }
    { const bool hi = (g & 4) != 0;
#pragma unroll
      for (int i = 0; i < 2; ++i) { const int send = hi ? r4[i] : r4[2 + i], keep = hi ? r4[2 + i] : r4[i]; r2[i] = keep + __shfl_xor(send, 32); } }
    *(unsigned*)op = pk_bf16(sa * (float)r2[0], sa * (float)r2[1]);
}
__device__ __forceinline__ void phase_peer_g3(const Frame& F, const Params& p, const u16* __restrict__ IDX, const unsigned char* __restrict__ ACT, bf16_t* __restrict__ OUT, int M, int qslot) {
    const unsigned char* V8 = p.ws + WS_TAB + TAB_V8;
    const float* SA = (const float*)(ACT + ACT_SA);
    unsigned* heads = (unsigned*)(p.ws + WS_CTL + WS_QUEUE) + (size_t)qslot * 8 * 64;
    const int nitems = M / (8 * PEER_TOK), myx = (int)(xb_xcc_id() & 7u), lane = F.lane, g = lane >> 3, c = lane & 7;
    for (int k = 0; k < 8; ++k) { const int x = (myx + k) & 7;
        const unsigned char* Vx = V8 + (size_t)x * TAB_SLICE + 16 * c; int pending = 0, pv = 0;
        const int col = 128 * x + 16 * c + 8 * (g & 1) + 4 * ((g >> 1) & 1) + 2 * ((g >> 2) & 1);
        for (;;) { const int item = q_next(F, heads + x * 64, pv, pending); pv = 1; if (item >= nitems) break;
            const int t0 = item * 8 * PEER_TOK + F.wave;
            G3Pre P[2]; u32x4 vv[2][16];
#pragma unroll
            for (int r = 0; r < 2; ++r) { const size_t t = (size_t)(t0 + 8 * r); P[r].id0 = IDX[t * 128 + lane]; P[r].id1 = IDX[t * 128 + 64 + lane];
                P[r].aq = *(const u32x4*)(ACT + t * 128 + g * 16); P[r].sa = SA[t]; }
            g1_issue(vv[0], P[0].id0, P[0].id1, Vx, g);
#pragma unroll
            for (int r = 0; r < PEER_TOK; ++r) { const int cur = r & 1;
                if (r + 1 < PEER_TOK) g1_issue(vv[cur ^ 1], P[cur ^ 1].id0, P[cur ^ 1].id1, Vx, g);
                const u32x4 aqc = P[cur].aq; const float sac = P[cur].sa;
                if (r + 2 < PEER_TOK) { const size_t t = (size_t)(t0 + 8 * (r + 2)); P[cur].id0 = IDX[t * 128 + lane]; P[cur].id1 = IDX[t * 128 + 64 + lane];
                    P[cur].aq = *(const u32x4*)(ACT + t * 128 + g * 16); P[cur].sa = SA[t]; }
                g3i_compute(vv[cur], aqc, sac, g, OUT + (size_t)(t0 + 8 * r) * 1024 + col); } } }
}
__device__ __forceinline__ void phase_final_norm(const Frame& F, const Params& p, const bf16_t* __restrict__ R, const bf16_t* __restrict__ OUT, const float* __restrict__ g5base) {
    f32x4 wv4[4];
#pragma unroll
    for (int i = 0; i < 4; ++i) wv4[i] = *(const f32x4*)(p.in[8] + 256 * i + 4 * F.lane);
    for (int row = F.bid * 8 + F.wave; row < ML; row += F.G * 8) {
        const bf16_t* sp = R + (size_t)row * 1024; const bf16_t* op = OUT + (size_t)row * 1024; const float* gp = g5base + (size_t)(row >> 12) * 6144;
        f32x4 x[4]; float ss = 0.f;
#pragma unroll
        for (int i = 0; i < 4; ++i) { const int col = 256 * i + 4 * F.lane; const u32x2 rv = *(const u32x2*)(sp + col); const f32x4 r = {bf_lo(rv[0]), bf_hi(rv[0]), bf_lo(rv[1]), bf_hi(rv[1])}, g5 = *(const f32x4*)(gp + col); const u32x2 o = *(const u32x2*)(op + col);
            x[i] = (f32x4){r[0] + g5[0] * bf_lo(o[0]), r[1] + g5[1] * bf_hi(o[0]), r[2] + g5[2] * bf_lo(o[1]), r[3] + g5[3] * bf_hi(o[1])};
            ss += x[i][0] * x[i][0] + x[i][1] * x[i][1] + x[i][2] * x[i][2] + x[i][3] * x[i][3]; }
        ss = wave_sum(ss);
        const float rs = rsqrtf(ss * (1.f / 1024.f) + NORM_EPS);
#pragma unroll
        for (int i = 0; i < 4; ++i) { const int col = 256 * i + 4 * F.lane; const f32x4 wv = wv4[i];
            *(f32x4*)(p.out + (size_t)row * 1024 + col) = (f32x4){x[i][0] * rs * wv[0], x[i][1] * rs * wv[1], x[i][2] * rs * wv[2], x[i][3] * rs * wv[3]}; }
    }
}

constexpr int GL_STR = 288, GL_VSTR = 144;
constexpr int GL_QG = 0, GL_KG = 64 * GL_STR, GL_V = 2 * 64 * GL_STR, GL_SET = GL_V + 64 * GL_VSTR;
constexpr int GL_ST = 2 * GL_SET, GL_AM = GL_ST + 2 * 16384, GL_DEC = GL_AM + 4 * 2048, GL_END = GL_DEC + 2 * 512;
static_assert(GL_END <= LDS_MISC, "GLA LDS map");
struct GlaRegs { u32x4 qv[2], gv[2], vv; };
__device__ __forceinline__ void gla_load(GlaRegs& R, const bf16_t* __restrict__ PA, int r0, int hg, int d, int vh, int tid, int lane, int wave) {
    const int t = d ? 63 - lane : lane; const bf16_t* rp = PA + (size_t)(r0 + t) * 4096 + hg * 128 + 16 * wave;
#pragma unroll
    for (int i = 0; i < 2; ++i) { R.qv[i] = *(const u32x4*)(rp + 8 * i); R.gv[i] = *(const u32x4*)(rp + 1024 + d * 1024 + 8 * i); }
    R.vv = *(const u32x4*)(PA + (size_t)(r0 + (tid >> 3)) * 4096 + 3072 + hg * 128 + vh * 64 + (tid & 7) * 8);
}
__device__ __forceinline__ void gla_stage(LAS unsigned char* lds, const GlaRegs& R, int set, int d, int tid, int lane, int wave) {
    const int sb = set * GL_SET, t = d ? 63 - lane : lane, kb = 16 * wave;
    float gc[16], kk[16], qq[16];
#pragma unroll
    for (int i = 0; i < 2; ++i)
#pragma unroll
        for (int e = 0; e < 8; ++e) { const float g = bf_one(dw_elem(R.gv[i], e)); kk[8 * i + e] = 1.f - __expf(g); qq[8 * i + e] = bf_one(dw_elem(R.qv[i], e)); gc[8 * i + e] = wave_incl_scan(g); }
    float qg[16], kg[16];
#pragma unroll
    for (int c = 0; c < 16; ++c) { qg[c] = qq[c] * __expf(gc[c]); kg[c] = kk[c] * __expf(-gc[c]); }
#pragma unroll
    for (int i = 0; i < 2; ++i) {
        *(LAS u32x4*)(lds + sb + GL_QG + t * GL_STR + ((kb >> 3) + i) * 16) = (u32x4){pk_bf16(qg[8 * i], qg[8 * i + 1]), pk_bf16(qg[8 * i + 2], qg[8 * i + 3]), pk_bf16(qg[8 * i + 4], qg[8 * i + 5]), pk_bf16(qg[8 * i + 6], qg[8 * i + 7])};
        *(LAS u32x4*)(lds + sb + GL_KG + t * GL_STR + ((kb >> 3) + i) * 16) = (u32x4){pk_bf16(kg[8 * i], kg[8 * i + 1]), pk_bf16(kg[8 * i + 2], kg[8 * i + 3]), pk_bf16(kg[8 * i + 4], kg[8 * i + 5]), pk_bf16(kg[8 * i + 6], kg[8 * i + 7])}; }
    if (lane == 63) {
#pragma unroll
        for (int i = 0; i < 4; ++i) *(LAS f32x4*)(lds + GL_DEC + set * 512 + (kb + 4 * i) * 4) = (f32x4){__expf(gc[4 * i]), __expf(gc[4 * i + 1]), __expf(gc[4 * i + 2]), __expf(gc[4 * i + 3])};
    }
    *(LAS u32x4*)(lds + sb + GL_V + (tid >> 3) * GL_VSTR + (tid & 7) * 16) = R.vv;
}
__device__ __forceinline__ void phase_gla(const Frame& F, const Params& p) {
    LAS unsigned char* lds = F.lds;
    const bf16_t* PA = (const bf16_t*)(p.ws + WS_PA);
    const int tid = F.tid, lane = F.lane, wave = F.wave, fr = lane & 15, fq = lane >> 4;
    const int tt = wave >> 1, vp = wave & 1;
    for (int u = F.bid; u < 256; u += F.G) {
        const int b = u >> 5, hg = (u >> 2) & 7, d = (u >> 1) & 1, vh = u & 1;
        bf16_t* O = (bf16_t*)((unsigned char*)p.out + (d ? DO_Y1 : 0));
        for (int i = tid; i < 1024; i += 512) *(LAS u32x4*)(lds + GL_ST + i * 16) = (u32x4){0u, 0u, 0u, 0u};
        f32x4 S[4];
#pragma unroll
        for (int i = 0; i < 4; ++i) S[i] = (f32x4){0.f, 0.f, 0.f, 0.f};
        GlaRegs R;
        gla_load(R, PA, chunk_row0(0, b, d), hg, d, vh, tid, lane, wave);
        gla_stage(lds, R, 0, d, tid, lane, wave);
        gla_load(R, PA, chunk_row0(1, b, d), hg, d, vh, tid, lane, wave);
        __syncthreads();
        for (int q = 0; q < 68; ++q) {
            const int set = q & 1, sb = set * GL_SET, r0 = chunk_row0(q, b, d); const bool lat = q >= 4;
            if (q + 1 < 68) gla_stage(lds, R, set ^ 1, d, tid, lane, wave);
            if (q + 2 < 68) gla_load(R, PA, chunk_row0(q + 2, b, d), hg, d, vh, tid, lane, wave);
            const int t = 16 * tt + fr;
            f32x4 oacc[2] = {{0.f, 0.f, 0.f, 0.f}, {0.f, 0.f, 0.f, 0.f}};
            if (lat) {
                bf16x8 qgf[4], stf[2][4];
#pragma unroll
                for (int ks = 0; ks < 4; ++ks) qgf[ks] = ld_row(lds, sb + GL_QG, GL_STR, tt, ks, lane);
                f32x4 aacc[4] = {{0.f, 0.f, 0.f, 0.f}, {0.f, 0.f, 0.f, 0.f}, {0.f, 0.f, 0.f, 0.f}, {0.f, 0.f, 0.f, 0.f}};
#pragma unroll
                for (int sh = 0; sh < 2; ++sh) {
                    bf16x8 kgf[2][4];
#pragma unroll
                    for (int si = 0; si < 2; ++si)
#pragma unroll
                        for (int ks = 0; ks < 4; ++ks) kgf[si][ks] = ld_row(lds, sb + GL_KG, GL_STR, 2 * sh + si, ks, lane);
                    __builtin_amdgcn_sched_barrier(0);
#pragma unroll
                    for (int ks = 0; ks < 4; ++ks)
#pragma unroll
                        for (int si = 0; si < 2; ++si) aacc[2 * sh + si] = mfma16(kgf[si][ks], qgf[ks], aacc[2 * sh + si]);
                    __builtin_amdgcn_sched_barrier(0);
                }
#pragma unroll
                for (int vs = 0; vs < 2; ++vs)
#pragma unroll
                    for (int ks = 0; ks < 4; ++ks) stf[vs][ks] = ld_frag(lds, GL_ST + set * 16384, 2 * vp + vs, ks, 4, lane);
                __builtin_amdgcn_sched_barrier(0);
#pragma unroll
                for (int ks = 0; ks < 4; ++ks)
#pragma unroll
                    for (int vs = 0; vs < 2; ++vs) oacc[vs] = mfma16(stf[vs][ks], qgf[ks], oacc[vs]);
#pragma unroll
                for (int si = 0; si < 4; ++si) { const int s0 = 16 * si + 4 * fq; float v[4];
#pragma unroll
                    for (int j = 0; j < 4; ++j) { const int s = s0 + j; const bool ok = d ? (s >= t) : (s <= t); v[j] = ok ? aacc[si][j] : 0.f; }
                    *(LAS u32x2*)(lds + GL_AM + tt * 2048 + frag_off(fr, s0 >> 3, 2) + (s0 & 7) * 2) = (u32x2){pk_bf16(v[0], v[1]), pk_bf16(v[2], v[3])}; }
            }
            __builtin_amdgcn_sched_barrier(0);
            bf16x8 ktf[2], vtf[4][2];
#pragma unroll
            for (int ks = 0; ks < 2; ++ks) { ktf[ks] = ld_tr(lds, sb + GL_KG, GL_STR, ks, 16 * wave, lane);
#pragma unroll
                for (int vt = 0; vt < 4; ++vt) vtf[vt][ks] = ld_tr(lds, sb + GL_V, GL_VSTR, ks, 16 * vt, lane); }
            const f32x4 dec = *(LAS f32x4*)(lds + GL_DEC + set * 512 + (16 * wave + 4 * fq) * 4);
            __builtin_amdgcn_sched_barrier(0);
#pragma unroll
            for (int ks = 0; ks < 2; ++ks)
#pragma unroll
                for (int vt = 0; vt < 4; ++vt) S[vt] = mfma16(ktf[ks], vtf[vt][ks], S[vt]);
#pragma unroll
            for (int vt = 0; vt < 4; ++vt) { S[vt][0] *= dec[0]; S[vt][1] *= dec[1]; S[vt][2] *= dec[2]; S[vt][3] *= dec[3]; }
            if (lat) {
                bf16x8 amf[2], vof[2][2];
#pragma unroll
                for (int ks = 0; ks < 2; ++ks) { amf[ks] = ld_frag(lds, GL_AM + tt * 2048, 0, ks, 2, lane);
#pragma unroll
                    for (int vs = 0; vs < 2; ++vs) vof[vs][ks] = ld_tr(lds, sb + GL_V, GL_VSTR, ks, 16 * (2 * vp + vs), lane); }
                __builtin_amdgcn_sched_barrier(0);
#pragma unroll
                for (int ks = 0; ks < 2; ++ks)
#pragma unroll
                    for (int vs = 0; vs < 2; ++vs) oacc[vs] = mfma16(vof[vs][ks], amf[ks], oacc[vs]);
                bf16_t* op = O + (size_t)(r0 + t) * 1024 + hg * 128 + vh * 64 + 32 * vp + 4 * fq;
#pragma unroll
                for (int vs = 0; vs < 2; ++vs) *(u32x2*)(op + 16 * vs) = (u32x2){pk_bf16(oacc[vs][0], oacc[vs][1]), pk_bf16(oacc[vs][2], oacc[vs][3])};
            }
            { const int k0 = 16 * wave + 4 * fq;
#pragma unroll
              for (int vt = 0; vt < 4; ++vt) *(LAS u32x2*)(lds + GL_ST + (set ^ 1) * 16384 + frag_off(16 * vt + fr, k0 >> 3, 4) + (k0 & 7) * 2) = (u32x2){pk_bf16(S[vt][0], S[vt][1]), pk_bf16(S[vt][2], S[vt][3])}; }
            __syncthreads();
        }
    }
}

__device__ __forceinline__ void phase_finish1(const Frame& F, const Params& p) {
    const bf16_t* O0 = (const bf16_t*)p.out; const bf16_t* O1 = (const bf16_t*)((const unsigned char*)p.out + DO_Y1);
    const bf16_t* SG = (const bf16_t*)(p.ws + WS_SG); bf16_t* A1 = (bf16_t*)(p.ws + WS_A1);
    const int c0 = F.lane * 16;
    f32x4 gn[4];
#pragma unroll
    for (int q = 0; q < 4; ++q) gn[q] = *(const f32x4*)(p.in[21] + c0 + 4 * q);
    for (int row = F.bid * 8 + F.wave; row < ML; row += F.G * 8) {
        const size_t o = (size_t)row * 1024 + c0;
        float v[16], sg[16]; float ss = 0.f;
#pragma unroll
        for (int i = 0; i < 2; ++i) { const u32x4 a = *(const u32x4*)(O0 + o + 8 * i), bq = *(const u32x4*)(O1 + o + 8 * i), s = *(const u32x4*)(SG + o + 8 * i);
#pragma unroll
            for (int e = 0; e < 8; ++e) { const float x = bf_one(dw_elem(a, e)) + bf_one(dw_elem(bq, e)); v[8 * i + e] = x; ss += x * x; sg[8 * i + e] = bf_one(dw_elem(s, e)); } }
        ss += __shfl_xor(ss, 1); ss += __shfl_xor(ss, 2); ss += __shfl_xor(ss, 4);
        const float rs = rsqrtf(ss * (1.f / 128.f) + NORM_EPS);
#pragma unroll
        for (int i = 0; i < 2; ++i) { const f32x4 g0 = gn[2 * i], g1 = gn[2 * i + 1];
            *(u32x4*)(A1 + o + 8 * i) = (u32x4){pk_bf16(v[8 * i] * rs * g0[0] * sg[8 * i], v[8 * i + 1] * rs * g0[1] * sg[8 * i + 1]), pk_bf16(v[8 * i + 2] * rs * g0[2] * sg[8 * i + 2], v[8 * i + 3] * rs * g0[3] * sg[8 * i + 3]),
                                              pk_bf16(v[8 * i + 4] * rs * g1[0] * sg[8 * i + 4], v[8 * i + 5] * rs * g1[1] * sg[8 * i + 5]), pk_bf16(v[8 * i + 6] * rs * g1[2] * sg[8 * i + 6], v[8 * i + 7] * rs * g1[3] * sg[8 * i + 7])}; }
    }
}

struct OneUnit { int pm, pn;
    __device__ bool next(int i, pg8::Unit& u) const { if (i != 0) return false; u.pm = pm; u.pn = pn; return true; }
    __device__ __forceinline__ void a_ready(const pg8::Unit&) const {}
    __device__ __forceinline__ void done(const pg8::Unit&) const {} };
constexpr int N_PHASES = 25;
#ifndef MK_ONE_LAUNCH
#define MK_ONE_LAUNCH 1
#endif
__global__ void __launch_bounds__(512, 2) fwd_kernel(Params p) {
    extern __shared__ __attribute__((aligned(16))) unsigned char lds_raw[];
    Frame F; F.lds = (LAS unsigned char*)lds_raw; F.tid = threadIdx.x; F.lane = F.tid & 63; F.wave = __builtin_amdgcn_readfirstlane(F.tid >> 6); F.bid = blockIdx.x; F.G = gridDim.x;
    volatile LAS unsigned* MISC = (volatile LAS unsigned*)(F.lds + LDS_MISC);
    if (F.tid < 4) MISC[F.tid] = 0u;
    __syncthreads();
    XcdBarrier bar = xcd_barrier_post((unsigned*)(p.ws + WS_CTL), MISC);
    const int lo = p.ph_lo, hi = p.ph_hi;
    unsigned char* ws = p.ws; unsigned char* dout = (unsigned char*)p.out;
    const float* MOD0 = (const float*)(ws + WS_MOD); const float* MOD1 = MOD0 + 9 * 6144;
    bf16_t* R = (bf16_t*)(ws + WS_R);
#define IN(k) (lo <= (k) && (k) < hi)
#define SEAM(k) do { if (IN((k) + 1)) xcd_barrier(bar); } while (0)
    if (IN(0)) { p0_prologue(F, p); SEAM(0); }
    if (IN(1)) { phase_norm<false>(F, p.in[0], p.in[2], MA, p.in[6], MOD0, 0, 1024, (bf16_t*)(dout + DO_H)); SEAM(1); }
    if (IN(2)) { pg8::Gemm g{(const bf16_t*)(dout + DO_H), (const bf16_t*)(ws + WS_WIN0), MA, NIN0, 1024}; pg8::StaticOrder S; S.init(MA, NIN0, F.G, F.bid);
        EpiIn0 E{(bf16_t*)(ws + WS_XBC), (bf16_t*)(ws + WS_P4), (float*)(ws + WS_DT)}; pg8::gemm_phase<EpiIn0, pg8::StaticOrder>(F.lds, g, S, E);
        convert_tables_dyn(F, p, 0, (unsigned*)(ws + WS_CTL + 61440 + 256 * p.rep), 0, 256); SEAM(2); }
    if (IN(3)) { phase_conv(F, p); SEAM(3); }
    if (IN(4)) { phase_ssd(F, p); SEAM(4); }
    if (IN(5)) {
        if (F.G >= 64 && F.bid < 32) {
            const int panel = F.bid >> 2;
            phase_finish0(F, p, ML + 256 * panel + F.wave, ML + 256 * panel + 256, 8);
            asm volatile("s_waitcnt vmcnt(0)" ::: "memory"); __syncthreads();
            pg8::Gemm g{(const bf16_t*)(ws + WS_A2), (const bf16_t*)(ws + WS_WOUT0), MA, 1024, 2048}; OneUnit S1{128 + panel, F.bid & 3};
            EpiResT<false> E{p.in[0], p.in[2], R, MOD0 + 2048}; pg8::gemm_phase<EpiResT<false>, OneUnit>(F.lds, g, S1, E);
        } else {
            const int nb = F.G >= 64 ? F.G - 32 : F.G, b0 = F.G >= 64 ? F.bid - 32 : F.bid;
            phase_finish0(F, p, b0 * 8 + F.wave, F.G >= 64 ? ML : MA, nb * 8);
        }
        SEAM(5); }
    if (IN(6)) { const int m6 = F.G >= 64 ? ML : MA; pg8::Gemm g{(const bf16_t*)(ws + WS_A2), (const bf16_t*)(ws + WS_WOUT0), m6, 1024, 2048}; pg8::StaticOrder S; S.init(m6, 1024, F.G, F.bid);
        EpiResT<false> E{p.in[0], p.in[2], R, MOD0 + 2048}; pg8::gemm_phase<EpiResT<false>, pg8::StaticOrder>(F.lds, g, S, E); SEAM(6); }
    if (IN(7)) { phase_norm<true>(F, R, R, MA, p.in[7], MOD0, 3072, 4096, (bf16_t*)(dout + DO_H), ws + WS_H8_0, (float*)(ws + WS_HS_0)); SEAM(7); }
    if (IN(8)) { pg8::Gemm g{(const bf16_t*)(dout + DO_H), (const bf16_t*)(ws + WS_WQ), MA, 2048, 1024}; pg8::StaticOrder S; S.init(MA, 2048, F.G, F.bid);
        EpiBf E{(bf16_t*)(ws + WS_Q0), 2048}; pg8::gemm_phase<EpiBf, pg8::StaticOrder>(F.lds, g, S, E);
        convert_tables_dyn(F, p, 0, (unsigned*)(ws + WS_CTL + 62464 + 256 * p.rep), 256, 256); SEAM(8); }
    if (IN(9)) { phase_topk(F, p, 0, (const bf16_t*)(ws + WS_Q0), MA, (u16*)(dout + DO_IDX0), (float*)(dout + DO_GATE0), (float*)(dout + DO_SU0)); SEAM(9); }
    if (IN(10)) { phase_peer_g1i(F, p, ws + WS_H8_0, (const u16*)(dout + DO_IDX0), (bf16_t*)(ws + WS_PART0), MA, 0 + 4 * p.rep); SEAM(10); }
    if (IN(11)) { phase_peer_g2(F, p, (const float*)(dout + DO_SU0), (const float*)(dout + DO_GATE0), (const float*)(ws + WS_HS_0), (const bf16_t*)(ws + WS_PART0), ws + WS_ACT0, MA); SEAM(11); }
    if (IN(12)) { phase_peer_g3(F, p, (const u16*)(dout + DO_IDX0), ws + WS_ACT0, (bf16_t*)(ws + WS_OUT0), MA, 1 + 4 * p.rep); SEAM(12); }
    if (IN(13)) { phase_norm<true>(F, R, R, MA, p.in[6] + 1024, MOD1, 0, 1024, (bf16_t*)(dout + DO_H), nullptr, nullptr, (const bf16_t*)(ws + WS_OUT0), MOD0 + 5 * 1024, R); SEAM(13); }
    if (IN(14)) { pg8::Gemm g{(const bf16_t*)(dout + DO_H), (const bf16_t*)(ws + WS_WIN1), MA, ODD_IN, 1024}; pg8::StaticOrder S; S.init(MA, ODD_IN, F.G, F.bid);
        EpiIn1 E{(bf16_t*)(ws + WS_PA), (bf16_t*)(ws + WS_SG), (const float*)(ws + WS_LB)}; pg8::gemm_phase<EpiIn1, pg8::StaticOrder>(F.lds, g, S, E); SEAM(14); }
    if (IN(15)) { phase_gla(F, p); SEAM(15); }
    if (IN(16)) { phase_finish1(F, p); SEAM(16); }
    if (IN(17)) { pg8::Gemm g{(const bf16_t*)(ws + WS_A1), (const bf16_t*)(ws + WS_WOUT1), ML, 1024, 1024}; pg8::StaticOrder S; S.init(ML, 1024, F.G, F.bid);
        unsigned* qh = (unsigned*)(ws + WS_CTL + 63488 + 512 * p.rep);
        if (F.bid & 1) convert_tables_dyn(F, p, 1, qh, 0, 256);
        EpiResT<true> E{nullptr, nullptr, R, MOD1 + 2048}; pg8::gemm_phase<EpiResT<true>, pg8::StaticOrder>(F.lds, g, S, E);
        convert_tables_dyn(F, p, 1, qh + 64, 256, 256);
        convert_tables_dyn(F, p, 1, qh, 0, 256);
        SEAM(17); }
    if (IN(18)) { phase_norm<true>(F, R, R, ML, p.in[7] + 1024, MOD1, 3072, 4096, (bf16_t*)(ws + WS_HF1), dout + DO_H8_1, (float*)(dout + DO_HS_1)); SEAM(18); }
    if (IN(19)) { pg8::Gemm g{(const bf16_t*)(ws + WS_HF1), (const bf16_t*)(ws + WS_WQ) + (size_t)2048 * 1024, ML, 2048, 1024}; pg8::StaticOrder S; S.init(ML, 2048, F.G, F.bid);
        EpiBf E{(bf16_t*)(ws + WS_Q1), 2048}; pg8::gemm_phase<EpiBf, pg8::StaticOrder>(F.lds, g, S, E); SEAM(19); }
    if (IN(20)) { phase_topk(F, p, 1, (const bf16_t*)(ws + WS_Q1), ML, (u16*)(ws + WS_IDX1), (float*)(ws + WS_GATE1), (float*)(ws + WS_SU1)); SEAM(20); }
    if (IN(21)) { phase_peer_g1i(F, p, dout + DO_H8_1, (const u16*)(ws + WS_IDX1), (bf16_t*)(ws + WS_PART1), ML, 2 + 4 * p.rep); SEAM(21); }
    if (IN(22)) { phase_peer_g2(F, p, (const float*)(ws + WS_SU1), (const float*)(ws + WS_GATE1), (const float*)(dout + DO_HS_1), (const bf16_t*)(ws + WS_PART1), ws + WS_ACT1, ML); SEAM(22); }
    if (IN(23)) { phase_peer_g3(F, p, (const u16*)(ws + WS_IDX1), ws + WS_ACT1, (bf16_t*)(ws + WS_OUT1), ML, 3 + 4 * p.rep); SEAM(23); }
    if (IN(24)) { phase_final_norm(F, p, R, (const bf16_t*)(ws + WS_OUT1), MOD1 + 5 * 1024); }
#undef IN
#undef SEAM
}


#ifdef DBG_STOP
__global__ void dump_kernel(const void* src, int is_f32, float* out, size_t n_src, size_t n) {
    for (size_t i = (size_t)blockIdx.x * blockDim.x + threadIdx.x; i < n; i += (size_t)gridDim.x * blockDim.x)
        out[i] = i < n_src ? (is_f32 ? ((const float*)src)[i] : __uint_as_float(((unsigned)((const unsigned short*)src)[i]) << 16)) : 0.f;
}
#endif
extern "C" void kernel_launch(void* const* d_in, const int* in_sizes, int n_in, void* d_out, int out_size, void* d_ws, size_t ws_size, hipStream_t stream) {
    static int grid = 0;
    if (grid == 0) {
        if (n_in != 26 || out_size != ML * D || ws_size < WS_END) { fprintf(stderr, "kernel_launch: unexpected problem (n_in %d, out %d, ws %zu < %zu)\n", n_in, out_size, ws_size, (size_t)WS_END); grid = -1; return; }
        int dev = 0, cus = 0, per_cu = 0;
        if (hipGetDevice(&dev) != hipSuccess || hipDeviceGetAttribute(&cus, hipDeviceAttributeMultiprocessorCount, dev) != hipSuccess) { grid = -1; return; }
        if (hipFuncSetAttribute((const void*)fwd_kernel, hipFuncAttributeMaxDynamicSharedMemorySize, LDS_BYTES) != hipSuccess) { fprintf(stderr, "kernel_launch: hipFuncSetAttribute failed\n"); grid = -1; return; }
        if (hipOccupancyMaxActiveBlocksPerMultiprocessor(&per_cu, (const void*)fwd_kernel, 512, LDS_BYTES) != hipSuccess || per_cu < 1) { fprintf(stderr, "kernel_launch: occupancy query says %d\n", per_cu); (void)hipGetLastError(); grid = -1; return; }
        grid = cus;
    }
    if (grid < 0) return;
    (void)hipMemsetAsync((char*)d_ws + WS_CTL, 0, CTL_BYTES, stream);
    Params p{};
    for (int i = 0; i < 26; ++i) p.in[i] = (const float*)d_in[i];
    p.out = (float*)d_out; p.ws = (unsigned char*)d_ws;
#if MK_ONE_LAUNCH
    p.ph_lo = 0; p.ph_hi = N_PHASES;
    hipLaunchKernelGGL(fwd_kernel, dim3(grid), dim3(512), LDS_BYTES, stream, p);
#elif defined(DBG_STOP)
    for (int k = 0; k <= DBG_STOP; ++k) { p.ph_lo = k; p.ph_hi = k + 1; hipLaunchKernelGGL(fwd_kernel, dim3(grid), dim3(512), LDS_BYTES, stream, p); }
    hipLaunchKernelGGL(dump_kernel, dim3(2048), dim3(256), 0, stream, (const void*)((unsigned char*)d_ws + DBG_SRC), DBG_F32, (float*)d_out, (size_t)DBG_N, (size_t)ML * D);
#else
    for (int k = 0; k < N_PHASES; ++k) { p.ph_lo = k; p.ph_hi = k + 1; hipLaunchKernelGGL(fwd_kernel, dim3(grid), dim3(512), LDS_BYTES, stream, p);
#ifdef DBG_REPMASK
        if ((DBG_REPMASK >> k) & 1) { p.rep = 1; hipLaunchKernelGGL(fwd_kernel, dim3(grid), dim3(512), LDS_BYTES, stream, p); p.rep = 0; }
#endif
    }
#endif
}
```

```cpp
#include <hip/hip_runtime.h>
#include <stdint.h>
#include <cstdio>

#define LAS __attribute__((address_space(3)))
typedef unsigned short u16;
typedef float f32x2 __attribute__((ext_vector_type(2)));
typedef unsigned u32x2 __attribute__((ext_vector_type(2)));
typedef __bf16 bf16v2 __attribute__((ext_vector_type(2)));

constexpr int D = 1024, NB = 8, SEQ = 4096, CTXL = 256;
constexpr int ML = NB * SEQ;
constexpr int MC = NB * CTXL;
constexpr int MA = ML + MC;
constexpr int EVEN_IN = 6176, ODD_IN = 5120;
constexpr int NIN0 = 6400;
constexpr float NORM_EPS = 1e-6f;

namespace pg8 {
#define PG8_LAS __attribute__((address_space(3)))
typedef unsigned short bf16_t;
typedef short bf16x8 __attribute__((ext_vector_type(8)));
typedef float f32x4 __attribute__((ext_vector_type(4)));
typedef unsigned u32x4 __attribute__((ext_vector_type(4)));
constexpr int BM = 256, BK = 64, HALF = 128, HTB = HALF * BK * 2  , STAGE_BYTES = 8 * HTB, NXCD = 8, WGM = 8;

__host__ __device__ __forceinline__ int lds_byte(int r, int c) { const int st = (r >> 4) * 2 + (c >> 5), rr = r & 15, cc = c & 31, ob = rr * 64 + cc * 2; return st * 1024 + (ob ^ (((ob >> 9) & 1) << 5)); }
__host__ __device__ __forceinline__ void stage_rc(int b, int& R, int& C) { const int st = b / 1024, sb = b % 1024, swz = sb ^ (((sb >> 9) & 1) << 5); R = (st >> 1) * 16 + swz / 64; C = (st & 1) * 32 + (swz % 64) / 2; }
__host__ __device__ __forceinline__ int perm32(int rho) { const int n = rho >> 4, i = rho & 15; return 8 * (i >> 2) + 4 * n + (i & 3); }

struct Unit { int pm, pn; };
struct Gemm { const bf16_t* A; const bf16_t* Bt; int M, N, K; };

struct StaticOrder {
    int nM, nN, nwg, G, c;
    __host__ __device__ void init(int M, int N, int G_, int c_) { nM = M / BM; nN = N / BM; nwg = nM * nN; G = G_; c = c_; }
    __host__ __device__ bool next(int i, Unit& u) const {
        const long L = (long)i * G + c; if (L >= nwg) return false;
        int wgid = (int)L; { const int q = nwg / NXCD, r = nwg % NXCD, xcd = wgid % NXCD, off = wgid / NXCD; wgid = (xcd < r ? xcd * (q + 1) : r * (q + 1) + (xcd - r) * q) + off; }
        const int nig = WGM * nN, gid = wgid / nig, fm = gid * WGM, gsz = (nM - fm) < WGM ? (nM - fm) : WGM;
        u.pm = fm + ((wgid % nig) % gsz); u.pn = (wgid % nig) / gsz; return true;
    }
    __device__ __forceinline__ void a_ready(const Unit&) const {}
    __device__ __forceinline__ void done(const Unit&) const {}
};


typedef int i32x4 __attribute__((ext_vector_type(4)));
template <bool I8> __device__ __forceinline__ f32x4 mma16(const bf16x8& b, const bf16x8& a, const f32x4& c) {
    if constexpr (I8) return __builtin_bit_cast(f32x4, __builtin_amdgcn_mfma_i32_16x16x64_i8(__builtin_bit_cast(i32x4, b), __builtin_bit_cast(i32x4, a), __builtin_bit_cast(i32x4, c), 0, 0, 0));
    else return __builtin_amdgcn_mfma_f32_16x16x32_bf16(b, a, c, 0, 0, 0);
}
template <class Epi> struct EpiI8 { template <class T> static constexpr auto test(int) -> decltype(T::I8) { return T::I8; } template <class T> static constexpr bool test(...) { return false; } static constexpr bool value = test<Epi>(0); };
template <class Epi, class Sched>
__device__ __forceinline__ void gemm_phase(PG8_LAS unsigned char* lds, const Gemm g, const Sched& S, const Epi& E) {
    const int tid = threadIdx.x, wid = __builtin_amdgcn_readfirstlane(tid >> 6), lane = tid & 63, wr = wid >> 2, wc = wid & 3, fr = lane & 15, fq = lane >> 4;
    const int K = g.K, nt = K / BK;
    unsigned voffA[2], voffB[2];
#pragma unroll
    for (int i = 0; i < 2; ++i) { int R, C; stage_rc(tid * 16 + i * 8192, R, C); const int Rb = Epi::PERM ? ((R & ~31) + perm32(R & 31)) : R;
        voffA[i] = (unsigned)(R * K + C) * 2u; voffB[i] = (unsigned)(Rb * K + C) * 2u; }
    const size_t kstep = (size_t)(BK * 2);
    const size_t hstep = (size_t)HALF * K * 2;
    const size_t tstep = 2 * hstep;
    const unsigned ldsw = (unsigned)wid * 1024u;
    const int aoff = lds_byte(wr * 64 + fr, fq * 8), boff = lds_byte(wc * 32 + fr, fq * 8);
#define PG8_SA(b, h) (((b) * 2 + (h)) * HTB)
#define PG8_SB(b, h) ((4 + (b) * 2 + (h)) * HTB)
#define PG8_STAGE(bufoff, gbase, voff) do { _Pragma("unroll") for (int _i = 0; _i < 2; ++_i) \
        __builtin_amdgcn_global_load_lds((const unsigned*)((const char*)(gbase) + (voff)[_i]), (PG8_LAS unsigned*)(lds + (bufoff) + ldsw + _i * 8192), 16, 0, 0); } while (0)
#define PG8_LDA(dst, b, h) do { _Pragma("unroll") for (int m = 0; m < 4; ++m) _Pragma("unroll") for (int k = 0; k < 2; ++k) dst[m][k] = *(const PG8_LAS bf16x8*)(lds + PG8_SA(b, h) + aoff + m * 2048 + k * 1024); } while (0)
#define PG8_LDB(dst, b, h) do { _Pragma("unroll") for (int n = 0; n < 2; ++n) _Pragma("unroll") for (int k = 0; k < 2; ++k) dst[n][k] = *(const PG8_LAS bf16x8*)(lds + PG8_SB(b, h) + boff + n * 2048 + k * 1024); } while (0)
#define PG8_MMA(ai, bj, At, Bt) do { __builtin_amdgcn_s_setprio(1); _Pragma("unroll") for (int m = 0; m < 4; ++m) _Pragma("unroll") for (int n = 0; n < 2; ++n) _Pragma("unroll") for (int k = 0; k < 2; ++k) \
        acc[ai][bj][m][n] = mma16<EpiI8<Epi>::value>(Bt[n][k], At[m][k], acc[ai][bj][m][n]); __builtin_amdgcn_s_setprio(0); } while (0)
#define PG8_WAIT_V(n) asm volatile("s_waitcnt vmcnt(" #n ")" ::: "memory")
#define PG8_WAIT_L(n) asm volatile("s_waitcnt lgkmcnt(" #n ")" ::: "memory")
#define PG8_BAR __builtin_amdgcn_s_barrier()
#define PG8_SCHED __builtin_amdgcn_sched_barrier(0)
    Unit cur, nxt; int ui = 0;
    if (!S.next(0, cur)) return;
    f32x4 acc[2][2][4][2];
#pragma unroll
    for (int a = 0; a < 2; ++a)
#pragma unroll
        for (int b = 0; b < 2; ++b)
#pragma unroll
            for (int m = 0; m < 4; ++m)
#pragma unroll
                for (int n = 0; n < 2; ++n) acc[a][b][m][n] = (f32x4){0.f, 0.f, 0.f, 0.f};
    bf16x8 At[4][2], B0[2][2], B1[2][2];
    const char* cA = (const char*)g.A + (size_t)cur.pm * tstep; const char* cB = (const char*)g.Bt + (size_t)cur.pn * tstep;
    S.a_ready(cur);
    PG8_STAGE(PG8_SB(0, 0), cB, voffB); PG8_STAGE(PG8_SA(0, 0), cA, voffA); PG8_STAGE(PG8_SB(0, 1), cB + hstep, voffB); PG8_STAGE(PG8_SA(0, 1), cA + hstep, voffA);
    if (wr == 1) PG8_BAR;
    PG8_WAIT_V(4); PG8_BAR;
    PG8_STAGE(PG8_SB(1, 0), cB + kstep, voffB); PG8_STAGE(PG8_SA(1, 0), cA + kstep, voffA); PG8_STAGE(PG8_SB(1, 1), cB + hstep + kstep, voffB);
    PG8_WAIT_V(6); PG8_BAR;
    for (;;) {
        const bool has_next = S.next(ui + 1, nxt);
        const char* nA = has_next ? (const char*)g.A + (size_t)nxt.pm * tstep : cA; const char* nB = has_next ? (const char*)g.Bt + (size_t)nxt.pn * tstep : cB;
        for (int t = 0; t < nt; t += 2) {
            const bool last = (t == nt - 2);
            const char* a1 = cA + (size_t)(t + 1) * kstep;
            const char* a2 = last ? nA : cA + (size_t)(t + 2) * kstep; const char* b2 = last ? nB : cB + (size_t)(t + 2) * kstep;
            const char* a3 = a2 + kstep; const char* b3 = b2 + kstep;
            if (last && has_next) S.a_ready(nxt);
            PG8_LDB(B0, 0, 0); PG8_SCHED; PG8_LDA(At, 0, 0); PG8_STAGE(PG8_SA(1, 1), a1 + hstep, voffA);
            PG8_WAIT_L(8); PG8_BAR; PG8_WAIT_L(0); PG8_MMA(0, 0, At, B0); PG8_BAR; PG8_SCHED;
            PG8_LDB(B1, 0, 1); PG8_STAGE(PG8_SB(0, 0), b2, voffB);
            PG8_BAR; PG8_WAIT_L(0); PG8_MMA(0, 1, At, B1); PG8_BAR;
            PG8_LDA(At, 0, 1); PG8_STAGE(PG8_SA(0, 0), a2, voffA);
            PG8_BAR; PG8_WAIT_L(0); PG8_MMA(1, 0, At, B0); PG8_BAR; PG8_SCHED;
            PG8_STAGE(PG8_SB(0, 1), b2 + hstep, voffB);
            PG8_WAIT_V(6); PG8_BAR; PG8_MMA(1, 1, At, B1); PG8_BAR;
            PG8_LDB(B0, 1, 0); PG8_SCHED; PG8_LDA(At, 1, 0); PG8_STAGE(PG8_SA(0, 1), a2 + hstep, voffA);
            PG8_WAIT_L(8); PG8_BAR; PG8_WAIT_L(0); PG8_MMA(0, 0, At, B0); PG8_BAR; PG8_SCHED;
            PG8_LDB(B1, 1, 1); PG8_STAGE(PG8_SB(1, 0), b3, voffB);
            PG8_BAR; PG8_WAIT_L(0); PG8_MMA(0, 1, At, B1); PG8_BAR;
            PG8_LDA(At, 1, 1); PG8_STAGE(PG8_SA(1, 0), a3, voffA);
            PG8_BAR; PG8_WAIT_L(0); PG8_MMA(1, 0, At, B0); PG8_BAR; PG8_SCHED;
            PG8_STAGE(PG8_SB(1, 1), b3 + hstep, voffB);
            PG8_WAIT_V(6); PG8_BAR; PG8_MMA(1, 1, At, B1); PG8_BAR;
        }
        if constexpr (EpiI8<Epi>::value) {
            const int r0q = cur.pm * 256 + wr * 64 + fr, c0q = cur.pn * 256 + wc * 32 + 8 * fq;
            f32x4 sbv[2][2];
#pragma unroll
            for (int b = 0; b < 2; ++b)
#pragma unroll
                for (int n = 0; n < 2; ++n) sbv[b][n] = *(const f32x4*)(E.SB + c0q + b * 128 + 4 * n);
#pragma unroll
            for (int a = 0; a < 2; ++a)
#pragma unroll
                for (int m = 0; m < 4; ++m) { const float sa = E.SA[r0q + a * 128 + m * 16];
#pragma unroll
                    for (int b = 0; b < 2; ++b)
#pragma unroll
                        for (int n = 0; n < 2; ++n) { const i32x4 q = __builtin_bit_cast(i32x4, acc[a][b][m][n]);
                            acc[a][b][m][n] = (f32x4){(float)q[0] * sa * sbv[b][n][0], (float)q[1] * sa * sbv[b][n][1], (float)q[2] * sa * sbv[b][n][2], (float)q[3] * sa * sbv[b][n][3]}; } }
        }
        if constexpr (!Epi::AFTER_DRAIN) { E(acc, cur, wr, wc, fr, fq); S.done(cur); }
        if (!has_next) break;
#pragma unroll
        for (int a = 0; a < 2; ++a)
#pragma unroll
            for (int b = 0; b < 2; ++b)
#pragma unroll
                for (int m = 0; m < 4; ++m)
#pragma unroll
                    for (int n = 0; n < 2; ++n) acc[a][b][m][n] = (f32x4){0.f, 0.f, 0.f, 0.f};
        cur = nxt; cA = nA; cB = nB; ++ui;
    }
    PG8_WAIT_V(0);
    if (wr == 0) PG8_BAR;
    PG8_BAR;
    if constexpr (Epi::AFTER_DRAIN) { E.fused(acc, cur, wr, wc, fr, fq, lds, wid, lane); S.done(cur); }
#undef PG8_SA
#undef PG8_SB
#undef PG8_STAGE
#undef PG8_LDA
#undef PG8_LDB
#undef PG8_MMA
#undef PG8_WAIT_V
#undef PG8_WAIT_L
#undef PG8_BAR
#undef PG8_SCHED
}
}

using pg8::bf16_t; using pg8::bf16x8; using pg8::f32x4; using pg8::u32x4;

#define XB_TMO      128
#define XB_XCNT(j)  (256  + 64 * (j))
#define XB_XSUB(j)  (1280 + 64 * (j))
#define XB_XGEN(j)  (2304 + 64 * (j))
#define XB_TOP      3328
#define XB_TOPGEN   3392
#define XCD_BAR_WORDS 3456
#define XB_SPIN_CAP (1u << 18)

__device__ __forceinline__ unsigned xb_ld(unsigned* p)              { return __hip_atomic_load(p, __ATOMIC_RELAXED, __HIP_MEMORY_SCOPE_AGENT); }
__device__ __forceinline__ unsigned xb_add(unsigned* p, unsigned v) { return __hip_atomic_fetch_add(p, v, __ATOMIC_RELAXED, __HIP_MEMORY_SCOPE_AGENT); }
__device__ __forceinline__ unsigned xb_xcc_id() { return (unsigned)__builtin_amdgcn_s_getreg((3 << 11) | 20) & 0xFu; }
#define XB_SPIN(cond, bar) do { unsigned _sp = 0; while (cond) { __builtin_amdgcn_s_sleep(1); \
    if ((++_sp & 255u) == 0u) { if (xb_ld(&(bar)[XB_TMO])) break; if (_sp > XB_SPIN_CAP) { atomicAdd(&(bar)[XB_TMO], 1u); break; } } } } while (0)

struct XcdBarrier {
    unsigned* bar; unsigned x;
    volatile LAS unsigned* st;
};

__device__ __forceinline__ XcdBarrier xcd_barrier_post(unsigned* bar, volatile LAS unsigned* st) {
    XcdBarrier b; b.bar = bar; b.x = xb_xcc_id(); b.st = st;
    if (threadIdx.x == 0) (void)xb_add(&bar[XB_XCNT(b.x)], 1u);
    return b;
}
__device__ __forceinline__ void xcd_barrier_complete(unsigned* bar, unsigned x, unsigned& nloc, unsigned& nx) {
    const unsigned G = gridDim.x * gridDim.y * gridDim.z;
    unsigned sum, cnt, mine, sp = 0u;
    for (;;) {
        sum = 0u; cnt = 0u; mine = 0u;
#pragma unroll
        for (unsigned j = 0; j < 16; ++j) { const unsigned c = xb_ld(&bar[XB_XCNT(j)]); sum += c; cnt += (c > 0u) ? 1u : 0u; mine = (j == x) ? c : mine; }
        if (sum == G) break;
        __builtin_amdgcn_s_sleep(1);
        if ((++sp & 255u) == 0u) { if (xb_ld(&bar[XB_TMO])) break; if (sp > XB_SPIN_CAP) { atomicAdd(&bar[XB_TMO], 1u); break; } }
    }
    nloc = mine > 0u ? mine : 1u; nx = cnt > 0u ? cnt : 1u;
}

__device__ __forceinline__ void xcd_barrier(const XcdBarrier& b) {
    asm volatile("s_waitcnt vmcnt(0)" ::: "memory");
    __syncthreads();
    if (threadIdx.x == 0) {
        unsigned* bar = b.bar;
        __builtin_amdgcn_s_waitcnt(0);
        unsigned nloc = b.st[0], nx = b.st[1];
        if (nloc == 0u) { xcd_barrier_complete(bar, b.x, nloc, nx); b.st[0] = nloc; b.st[1] = nx; }
        const unsigned old = xb_add(&bar[XB_XSUB(b.x)], 1u);
        const unsigned gen = old / nloc;
        if (old + 1u == (gen + 1u) * nloc) {
            __builtin_amdgcn_fence(__ATOMIC_RELEASE, "agent");
            asm volatile("s_waitcnt vmcnt(0)" ::: "memory");
            const unsigned og = xb_add(&bar[XB_TOP], 1u);
            const unsigned tg = og / nx;
            if (og + 1u == (tg + 1u) * nx) xb_add(&bar[XB_TOPGEN], 1u);
            else XB_SPIN(xb_ld(&bar[XB_TOPGEN]) == tg, bar);
            __builtin_amdgcn_fence(__ATOMIC_ACQUIRE, "agent");
            xb_add(&bar[XB_XGEN(b.x)], 1u);
            asm volatile("s_waitcnt vmcnt(0)" ::: "memory");
        } else {
            XB_SPIN(xb_ld(&bar[XB_XGEN(b.x)]) == gen, bar);
            __builtin_amdgcn_fence(__ATOMIC_ACQUIRE, "agent");
            asm volatile("s_waitcnt vmcnt(0)" ::: "memory");
        }
    }
    __syncthreads();
}

__device__ __forceinline__ unsigned pk_bf16(float lo, float hi) { bf16v2 v = {(__bf16)lo, (__bf16)hi}; return __builtin_bit_cast(unsigned, v); }
__device__ __forceinline__ float bf_lo(unsigned u) { return __uint_as_float(u << 16); }
__device__ __forceinline__ float bf_hi(unsigned u) { return __uint_as_float(u & 0xffff0000u); }
__device__ __forceinline__ float bf_one(u16 u) { return __uint_as_float(((unsigned)u) << 16); }
__device__ __forceinline__ float fast_rcp(float x) { return __builtin_amdgcn_rcpf(x); }
__device__ __forceinline__ float silu_f(float x) { return x * fast_rcp(1.f + __expf(-x)); }
__device__ __forceinline__ float sigmoid_f(float x) { return fast_rcp(1.f + __expf(-x)); }
__device__ __forceinline__ float wave_sum(float v) {
#pragma unroll
    for (int o = 32; o; o >>= 1) v += __shfl_xor(v, o);
    return v;
}
__device__ __forceinline__ u32x4 pk8(const f32x4& a, const f32x4& b) { return (u32x4){pk_bf16(a[0], a[1]), pk_bf16(a[2], a[3]), pk_bf16(b[0], b[1]), pk_bf16(b[2], b[3])}; }
__device__ __forceinline__ int frag_off(int r, int k8, int KB) { return ((r >> 4) * KB + (k8 >> 2)) * 1024 + (((k8 & 3) << 4) + (r & 15)) * 16; }
__device__ __forceinline__ bf16x8 ld_frag(LAS unsigned char* lds, int base, int rt, int ks, int KB, int lane) { return *(const LAS bf16x8*)(lds + base + (rt * KB + ks) * 1024 + lane * 16); }
__device__ __forceinline__ f32x4 mfma16(bf16x8 a, bf16x8 b, f32x4 c) { return __builtin_amdgcn_mfma_f32_16x16x32_bf16(a, b, c, 0, 0, 0); }

#define EPI_ARGS const f32x4 (&acc)[2][2][4][2], const pg8::Unit& u, int wr, int wc, int fr, int fq

struct EpiIn0 {
    static constexpr bool PERM = true, AFTER_DRAIN = false, I8 = true;
    bf16_t* XBC; bf16_t* P4; float* DT; const float* SA; const float* SB;
    __device__ __forceinline__ void operator()(EPI_ARGS) const {
        const int row0 = u.pm * 256 + wr * 64 + fr, cl = wc * 32 + 8 * fq, pn = u.pn;
        if (pn < 8) {
#pragma unroll
            for (int ai = 0; ai < 2; ++ai)
#pragma unroll
                for (int m = 0; m < 4; ++m) { bf16_t* rp = XBC + (size_t)(row0 + ai * 128 + m * 16) * 2048 + pn * 256 + cl;
#pragma unroll
                    for (int bj = 0; bj < 2; ++bj) *(u32x4*)(rp + bj * 128) = pk8(acc[ai][bj][m][0], acc[ai][bj][m][1]); }
        } else if (pn < 16) {
#pragma unroll
            for (int ai = 0; ai < 2; ++ai)
#pragma unroll
                for (int m = 0; m < 4; ++m) { bf16_t* rp = P4 + (size_t)(row0 + ai * 128 + m * 16) * 3072 + (pn - 8) * 128 + cl;
                    *(u32x4*)rp = pk8(acc[ai][0][m][0] * acc[ai][1][m][0], acc[ai][0][m][1] * acc[ai][1][m][1]); }
        } else if (pn < 20) {
#pragma unroll
            for (int ai = 0; ai < 2; ++ai)
#pragma unroll
                for (int m = 0; m < 4; ++m) { bf16_t* rp = P4 + (size_t)(row0 + ai * 128 + m * 16) * 3072 + 1024 + (pn - 16) * 256 + cl;
#pragma unroll
                    for (int bj = 0; bj < 2; ++bj) *(u32x4*)(rp + bj * 128) = pk8(acc[ai][bj][m][0], acc[ai][bj][m][1]); }
        } else if (pn < 24) {
#pragma unroll
            for (int ai = 0; ai < 2; ++ai)
#pragma unroll
                for (int m = 0; m < 4; ++m) { bf16_t* rp = P4 + (size_t)(row0 + ai * 128 + m * 16) * 3072 + 2048 + (pn - 20) * 256 + cl;
#pragma unroll
                    for (int bj = 0; bj < 2; ++bj) { f32x4 a = acc[ai][bj][m][0], b = acc[ai][bj][m][1];
#pragma unroll
                        for (int i = 0; i < 4; ++i) { a[i] = silu_f(a[i]); b[i] = silu_f(b[i]); }
                        *(u32x4*)(rp + bj * 128) = pk8(a, b); } }
        } else if (wc == 0) {
#pragma unroll
            for (int ai = 0; ai < 2; ++ai)
#pragma unroll
                for (int m = 0; m < 4; ++m) { float* rp = DT + (size_t)(row0 + ai * 128 + m * 16) * 32 + 8 * fq;
                    *(f32x4*)rp = acc[ai][0][m][0]; *(f32x4*)(rp + 4) = acc[ai][0][m][1]; }
        }
    }
};
template <bool SRC_BF>
struct EpiResT {
    static constexpr bool PERM = true, AFTER_DRAIN = false, I8 = true;
    const float* srcL; const float* srcC; bf16_t* R; const float* gate; const float* SA; const float* SB;
    __device__ __forceinline__ void operator()(EPI_ARGS) const {
        const int row0 = u.pm * 256 + wr * 64 + fr, col0 = u.pn * 256 + wc * 32 + 8 * fq;
        const int j = u.pm < 128 ? (u.pm >> 4) : 8;
        const float* gp = gate + (size_t)j * 6144 + col0;
        f32x4 gv[2][2];
#pragma unroll
        for (int bj = 0; bj < 2; ++bj)
#pragma unroll
            for (int n = 0; n < 2; ++n) gv[bj][n] = *(const f32x4*)(gp + bj * 128 + 4 * n);
#pragma unroll
        for (int ai = 0; ai < 2; ++ai)
#pragma unroll
            for (int m = 0; m < 4; ++m) { const int row = row0 + ai * 128 + m * 16; bf16_t* rp = R + (size_t)row * 1024 + col0;
#pragma unroll
                for (int bj = 0; bj < 2; ++bj) { f32x4 s0, s1;
                    if (SRC_BF) { const u32x4 sv = *(const u32x4*)(rp + bj * 128); s0 = (f32x4){bf_lo(sv[0]), bf_hi(sv[0]), bf_lo(sv[1]), bf_hi(sv[1])}; s1 = (f32x4){bf_lo(sv[2]), bf_hi(sv[2]), bf_lo(sv[3]), bf_hi(sv[3])}; }
                    else { const float* sp = (row < ML ? srcL + (size_t)row * 1024 : srcC + (size_t)(row - ML) * 1024) + col0 + bj * 128; s0 = *(const f32x4*)sp; s1 = *(const f32x4*)(sp + 4); }
                    *(u32x4*)(rp + bj * 128) = pk8(s0 + gv[bj][0] * acc[ai][bj][m][0], s1 + gv[bj][1] * acc[ai][bj][m][1]); } }
    }
};
struct EpiBf {
    static constexpr bool PERM = true, AFTER_DRAIN = false, I8 = true;
    bf16_t* O; int ldc; const float* SA; const float* SB;
    __device__ __forceinline__ void operator()(EPI_ARGS) const {
        const int row0 = u.pm * 256 + wr * 64 + fr, col0 = u.pn * 256 + wc * 32 + 8 * fq;
#pragma unroll
        for (int ai = 0; ai < 2; ++ai)
#pragma unroll
            for (int m = 0; m < 4; ++m) { bf16_t* rp = O + (size_t)(row0 + ai * 128 + m * 16) * ldc + col0;
#pragma unroll
                for (int bj = 0; bj < 2; ++bj) *(u32x4*)(rp + bj * 128) = pk8(acc[ai][bj][m][0], acc[ai][bj][m][1]); }
    }
};
struct EpiIn1 {
    static constexpr bool PERM = true, AFTER_DRAIN = false, I8 = true;
    bf16_t* PA; bf16_t* SG; const float* LB; const float* SA; const float* SB;
    __device__ __forceinline__ void operator()(EPI_ARGS) const {
        const int row0 = u.pm * 256 + wr * 64 + fr, cl = wc * 32 + 8 * fq, pn = u.pn, grp = pn >> 2, cg = (pn & 3) * 256 + cl;
        if (grp == 4 && u.pm >= 128) return;
#pragma unroll
        for (int bj = 0; bj < 2; ++bj) {
            f32x4 lb0 = {0.f, 0.f, 0.f, 0.f}, lb1 = {0.f, 0.f, 0.f, 0.f};
            if (grp == 1 || grp == 2) { const float* lp = LB + (grp - 1) * 1024 + cg + bj * 128; lb0 = *(const f32x4*)lp; lb1 = *(const f32x4*)(lp + 4); }
#pragma unroll
            for (int ai = 0; ai < 2; ++ai)
#pragma unroll
                for (int m = 0; m < 4; ++m) { const size_t row = (size_t)(row0 + ai * 128 + m * 16);
                    f32x4 a = acc[ai][bj][m][0], b = acc[ai][bj][m][1];
                    if (grp == 0) {
#pragma unroll
                        for (int i = 0; i < 4; ++i) { a[i] = silu_f(a[i]) * 0.08838834764831845f; b[i] = silu_f(b[i]) * 0.08838834764831845f; }
                    } else if (grp == 1 || grp == 2) {
#pragma unroll
                        for (int i = 0; i < 4; ++i) { a[i] = __log2f(lb0[i] + (1.f - lb0[i]) * sigmoid_f(a[i])); b[i] = __log2f(lb1[i] + (1.f - lb1[i]) * sigmoid_f(b[i])); }
                    } else if (grp == 4) {
#pragma unroll
                        for (int i = 0; i < 4; ++i) { a[i] = silu_f(a[i]); b[i] = silu_f(b[i]); }
                    }
                    bf16_t* rp = (grp == 4) ? SG + row * 1024 + cg + bj * 128 : PA + row * 4096 + ((grp * 1024 + cg + bj * 128 + 64 * (int)(row & 15)) & 4095);
                    *(u32x4*)rp = pk8(a, b); }
        }
    }
};

constexpr size_t MiB = (size_t)1 << 20;
constexpr size_t WS_CTL = 0;
constexpr size_t WS_MOD = 65536;
constexpr size_t WS_LB = WS_MOD + (size_t)2 * 9 * 6144 * 4;
constexpr size_t WS_WIN0 = 1 * MiB;
constexpr size_t WS_WOUT0 = WS_WIN0 + (size_t)NIN0 * 1024 * 2;
constexpr size_t WS_WIN1 = WS_WOUT0 + (size_t)1024 * 2048 * 2;
constexpr size_t WS_WOUT1 = WS_WIN1 + (size_t)5120 * 1024 * 2;
constexpr size_t WS_WQ = WS_WOUT1 + (size_t)1024 * 1024 * 2;
constexpr size_t WS_KEYS = WS_WQ + (size_t)2 * 2048 * 1024 * 2;
constexpr size_t WS_WEND = WS_KEYS + (size_t)2 * 8 * 2 * 128 * 128 * 2;
static_assert(WS_WEND <= 39 * MiB, "weights");
constexpr size_t WS_TAB = 39 * MiB;
constexpr size_t WS_Z1 = 103 * MiB;
constexpr size_t WS_Z2 = 239 * MiB;
constexpr size_t WS_R = 375 * MiB;
constexpr size_t WS_TAB1 = 456 * MiB;
constexpr size_t WS_W8OUT0 = 489 * MiB, WS_W8OUT1 = 491 * MiB;
constexpr size_t WS_W8Q = 492 * MiB;
constexpr size_t WS_AS2 = 496 * MiB + 512 * 1024;
constexpr size_t WS_SBO0 = 496 * MiB + 768 * 1024, WS_SBO1 = WS_SBO0 + 8192, WS_SBQ = WS_SBO1 + 8192;
constexpr size_t WS_AS = 496 * MiB;
constexpr size_t WS_W8IN0 = 497 * MiB;
constexpr size_t WS_W8IN1 = 504 * MiB;
constexpr size_t WS_SB0 = 509 * MiB, WS_SB1 = WS_SB0 + 32768;
constexpr size_t WS_END = 511 * MiB;
constexpr size_t WS_XBC = WS_Z1;
constexpr size_t WS_A2 = WS_Z1;
constexpr size_t WS_Q0 = WS_Z1;
constexpr size_t WS_P4 = WS_Z2;
constexpr size_t WS_DT = 443 * MiB;
constexpr size_t WS_YC = 448 * MiB;
constexpr size_t WS_PA = WS_Z1;
constexpr size_t WS_SG = WS_TAB;
constexpr size_t WS_A1 = WS_Z1;
constexpr size_t WS_HF1 = WS_Z1;
constexpr size_t WS_IDX1 = WS_Z1 + 64 * MiB;
constexpr size_t WS_GATE1 = WS_Z1 + 72 * MiB;
constexpr size_t WS_Q1 = WS_Z2;
constexpr size_t WS_PART0 = WS_Z1;
constexpr size_t WS_ACT0 = WS_Z2;
constexpr size_t WS_PART1 = WS_Z2;
constexpr size_t WS_ACT1 = WS_Z1 + 88 * MiB;
constexpr size_t DO_SU0 = 94 * MiB;
constexpr size_t WS_SU1 = WS_Z1 + 104 * MiB;
constexpr size_t WS_H8_0 = WS_Z2 + 17 * MiB;
constexpr size_t WS_HS_0 = WS_H8_0 + 34 * MiB;
constexpr size_t DO_H8_1 = 0;
constexpr size_t DO_HS_1 = 32 * MiB;
constexpr size_t ACT_SA = (size_t)8 * MiB;
constexpr size_t WS_OUT0 = WS_Z1;
constexpr size_t WS_OUT1 = WS_Z2;
constexpr size_t CTL_BYTES = 65536;
constexpr size_t DO_H = 0;
constexpr size_t DO_Y1 = 64 * MiB;
constexpr size_t DO_IDX0 = 68 * MiB;
constexpr size_t DO_GATE0 = 77 * MiB;
constexpr int LDS_BYTES = 163840;
constexpr int LDS_MISC = 163840 - 512;

struct Params { const float* in[26]; float* out; unsigned char* ws; int ph_lo, ph_hi, rep, pad; };
struct Frame { LAS unsigned char* lds; int tid, lane, wave, bid, G; };

struct TrTile { const float* src; bf16_t* dst; int ld, K, k0, c0, nv, n0; };
__device__ __forceinline__ void tr_load(const Frame& F, const TrTile& t, f32x4 (&v)[2]) {
    const int kk = F.tid >> 4, n4 = (F.tid & 15) * 4;
#pragma unroll
    for (int i = 0; i < 2; ++i) { v[i] = (f32x4){0.f, 0.f, 0.f, 0.f}; if (n4 < t.nv) v[i] = *(const f32x4*)(t.src + (size_t)(t.k0 + kk + 32 * i) * t.ld + t.c0 + n4); }
}
__device__ __forceinline__ void tr_finish(const Frame& F, const TrTile& t, const f32x4 (&v)[2]) {
    LAS float* tile = (LAS float*)F.lds;
    const int kk = F.tid >> 4, n4 = (F.tid & 15) * 4;
#pragma unroll
    for (int i = 0; i < 2; ++i) { const int k = kk + 32 * i; tile[k * 65 + n4] = v[i][0]; tile[k * 65 + n4 + 1] = v[i][1]; tile[k * 65 + n4 + 2] = v[i][2]; tile[k * 65 + n4 + 3] = v[i][3]; }
    __syncthreads();
    const int n = F.tid >> 3, k8 = F.tid & 7;
    float f[8];
#pragma unroll
    for (int e = 0; e < 8; ++e) f[e] = tile[(8 * k8 + e) * 65 + n];
    *(u32x4*)(t.dst + (size_t)(t.n0 + n) * t.K + t.k0 + 8 * k8) = (u32x4){pk_bf16(f[0], f[1]), pk_bf16(f[2], f[3]), pk_bf16(f[4], f[5]), pk_bf16(f[6], f[7])};
    __syncthreads();
}
__device__ __forceinline__ TrTile tr_decode(const Params& p, int u) {
    unsigned char* ws = p.ws; TrTile t; int nt, kt; t.nv = 64;
    if (u < 1600) { nt = u >> 4; kt = u & 15; t.src = p.in[9]; t.ld = EVEN_IN; t.K = 1024; t.dst = (bf16_t*)(ws + WS_WIN0);
        if (nt < 32) t.c0 = 4096 + 64 * nt;
        else if (nt < 64) { const int uu = nt - 32, j = uu >> 2, q = uu & 3; t.c0 = q < 2 ? 128 * j + 64 * q : 2048 + 128 * j + 64 * (q - 2); }
        else if (nt < 80) t.c0 = 1024 + 64 * (nt - 64);
        else if (nt < 96) t.c0 = 3072 + 64 * (nt - 80);
        else if (nt == 96) { t.c0 = 6144; t.nv = 32; }
        else { t.c0 = 0; t.nv = 0; } }
    else if (u < 2112) { const int v = u - 1600; nt = v >> 5; kt = v & 31; t.src = p.in[10]; t.ld = 1024; t.K = 2048; t.dst = (bf16_t*)(ws + WS_WOUT0); t.c0 = 64 * nt; }
    else if (u < 3392) { const int v = u - 2112; nt = v >> 4; kt = v & 15; t.src = p.in[18]; t.ld = ODD_IN; t.K = 1024; t.dst = (bf16_t*)(ws + WS_WIN1); t.c0 = 64 * nt; }
    else if (u < 3648) { const int v = u - 3392; nt = v >> 4; kt = v & 15; t.src = p.in[19]; t.ld = 1024; t.K = 1024; t.dst = (bf16_t*)(ws + WS_WOUT1); t.c0 = 64 * nt; }
    else { const int v = u - 3648, layer = v >> 9, w = v & 511; nt = w >> 4; kt = w & 15; t.src = p.in[22] + (size_t)layer * 1024 * 2048; t.ld = 2048; t.K = 1024; t.dst = (bf16_t*)(ws + WS_WQ) + (size_t)layer * 2048 * 1024; t.c0 = 64 * nt; }
    t.k0 = kt * 64; t.n0 = nt * 64; return t;
}
__device__ __forceinline__ void cvt8(const float* __restrict__ s, bf16_t* __restrict__ d) {
    const f32x4 a = *(const f32x4*)s, b = *(const f32x4*)(s + 4); *(u32x4*)d = pk8(a, b);
}
__device__ __forceinline__ unsigned pack_i8x4(const f32x4& x, float sc) {
    unsigned w = 0;
#pragma unroll
    for (int e = 0; e < 4; ++e) { const int q = max(-127, min(127, __float2int_rn(x[e] * sc))); w |= ((unsigned)q & 0xffu) << (8 * e); }
    return w;
}
constexpr size_t TAB_V8 = (size_t)16 * MiB, TAB_SCU = (size_t)32 * MiB, TAB_SCV = TAB_SCU + 65536, TAB_SLICE = (size_t)2 * MiB;
template <int NR>
__device__ __forceinline__ void convert_rows(const Frame& F, const Params& p, int layer, const int (&rows)[NR]) {
    unsigned char* tab = p.ws + (layer ? WS_TAB1 : WS_TAB);
    f32x4 x[NR][4];
#pragma unroll
    for (int k = 0; k < NR; ++k) { const int t = rows[k] >> 14, r = rows[k] & 16383;
        const float* sp = (t ? p.in[25] : p.in[24]) + (size_t)layer * 16384 * 1024 + (size_t)r * 1024 + 16 * F.lane;
#pragma unroll
        for (int i = 0; i < 4; ++i) x[k][i] = *(const f32x4*)(sp + 4 * i); }
#pragma unroll
    for (int k = 0; k < NR; ++k) { const int t = rows[k] >> 14, r = rows[k] & 16383;
        if (t == 0) {
            float ss = 0.f;
#pragma unroll
            for (int i = 0; i < 4; ++i) ss += x[k][i][0] * x[k][i][0] + x[k][i][1] * x[k][i][1] + x[k][i][2] * x[k][i][2] + x[k][i][3] * x[k][i][3];
            ss = wave_sum(ss);
            const float step = ss > 0.f ? 0.35f * sqrtf(ss * (1.f / 1024.f)) : 1.f, sc = 1.f / step;
            u32x2 o = {0u, 0u};
#pragma unroll
            for (int i = 0; i < 4; ++i)
#pragma unroll
                for (int e = 0; e < 4; ++e) { const int q = max(-7, min(7, __float2int_rn(x[k][i][e] * sc))); o[i >> 1] |= ((unsigned)q & 15u) << (4 * (4 * (i & 1) + e)); }
            *(u32x2*)(tab + (size_t)(F.lane >> 4) * TAB_SLICE + (size_t)r * 128 + 8 * (F.lane & 15)) = o;
            if (F.lane == 0) ((float*)(tab + TAB_SCU))[r] = step;
        } else {
            float ss = 0.f;
#pragma unroll
            for (int i = 0; i < 4; ++i) ss += x[k][i][0] * x[k][i][0] + x[k][i][1] * x[k][i][1] + x[k][i][2] * x[k][i][2] + x[k][i][3] * x[k][i][3];
            ss = wave_sum(ss);
            const float step = ss > 0.f ? 0.35f * sqrtf(ss * (1.f / 1024.f)) : 1.f, sc = 1.f / step;
            const int gi = (F.lane & 15) >> 2;
#pragma unroll
            for (int e = 0; e < 4; ++e) { unsigned w = 0;
#pragma unroll
                for (int i = 0; i < 4; ++i) { const int q = max(-7, min(7, __float2int_rn(x[k][i][e] * sc))); w |= ((unsigned)q & 15u) << (4 * i); }
                *(u16*)(tab + TAB_V8 + (size_t)(F.lane >> 4) * TAB_SLICE + (size_t)r * 128 + 32 * e + 8 * gi + 2 * (F.lane & 3)) = (u16)w; }
            if (F.lane == 0) ((float*)(tab + TAB_SCV))[r] = step; } }
}
__device__ __forceinline__ void convert_tables(const Frame& F, const Params& p, int layer) {
    const int stride = F.G * 8;
    for (int row = F.bid * 8 + F.wave; row < 32768; row += 4 * stride) {
        if (row + 3 * stride < 32768) { const int rows[4] = {row, row + stride, row + 2 * stride, row + 3 * stride}; convert_rows<4>(F, p, layer, rows); }
        else for (int r2 = row; r2 < 32768; r2 += stride) { const int rows[1] = {r2}; convert_rows<1>(F, p, layer, rows); }
    }
}
__device__ __forceinline__ void convert_tables_dyn(const Frame& F, const Params& p, int layer, unsigned* head, int chunk0, int nchunks) {
    volatile LAS int* w = (volatile LAS int*)(F.lds + LDS_MISC + 64);
    for (;;) {
        if (F.tid == 0) *w = (int)__hip_atomic_fetch_add(head, 1u, __ATOMIC_RELAXED, __HIP_MEMORY_SCOPE_AGENT);
        __syncthreads();
        const int ticket = *w;
        __syncthreads();
        if (ticket >= nchunks) break;
        const int chunk = chunk0 + ticket;
#pragma unroll 1
        for (int rr = 0; rr < 8; rr += 4) { const int r0 = chunk * 64 + rr * 8 + F.wave; const int rows[4] = {r0, r0 + 8, r0 + 16, r0 + 24}; convert_rows<4>(F, p, layer, rows); }
    }
}
__device__ __forceinline__ void p0_prologue(const Frame& F, const Params& p) {
    unsigned char* ws = p.ws;
    for (int u = F.bid; u < 192; u += F.G) {
        const int layer = u / 96, cg = u % 96;
        LAS float* sc = (LAS float*)F.lds; LAS float* red = sc + 9 * 1024;
        for (int e = F.tid; e < 9216; e += 512) { const int j = e >> 10, k = e & 1023; const float cv = j < 8 ? p.in[1][j * 1024 + k] : p.in[3][k]; sc[e] = silu_f(cv); }
        __syncthreads();
        const int col = F.tid & 63, ks = F.tid >> 6;
        float acc[9];
#pragma unroll
        for (int j = 0; j < 9; ++j) acc[j] = 0.f;
        const float* wp = p.in[4] + (size_t)layer * 1024 * 6144 + (size_t)(ks * 128) * 6144 + cg * 64 + col;
        for (int k0 = 0; k0 < 128; k0 += 16) { float wv[16];
#pragma unroll
            for (int k = 0; k < 16; ++k) wv[k] = wp[(size_t)(k0 + k) * 6144];
#pragma unroll
            for (int k = 0; k < 16; ++k)
#pragma unroll
                for (int j = 0; j < 9; ++j) acc[j] += sc[j * 1024 + ks * 128 + k0 + k] * wv[k]; }
#pragma unroll
        for (int j = 0; j < 9; ++j) red[(ks * 9 + j) * 64 + col] = acc[j];
        __syncthreads();
        for (int e = F.tid; e < 576; e += 512) { const int j = e >> 6, c = e & 63; float s = 0.f;
#pragma unroll
            for (int q = 0; q < 8; ++q) s += red[(q * 9 + j) * 64 + c];
            ((float*)(ws + WS_MOD))[(size_t)(layer * 9 + j) * 6144 + cg * 64 + c] = s + p.in[5][layer * 6144 + cg * 64 + c]; }
        __syncthreads();
    }
    for (int e = F.bid * 512 + F.tid; e < 2048; e += F.G * 512) { const float l0 = p.in[20][e], l1 = p.in[20][2048 + e]; ((float*)(ws + WS_LB))[e] = fast_rcp(1.f + __expf(l0 - l1)); }
    if (F.bid < 4672) {
        TrTile cur = tr_decode(p, F.bid); f32x4 v[2]; tr_load(F, cur, v);
        for (int u = F.bid; u < 4672; u += F.G) {
            const int un = u + F.G; TrTile nxt = cur; f32x4 vn[2] = {{0.f, 0.f, 0.f, 0.f}, {0.f, 0.f, 0.f, 0.f}};
            if (un < 4672) { nxt = tr_decode(p, un); tr_load(F, nxt, vn); }
            tr_finish(F, cur, v);
            cur = nxt; v[0] = vn[0]; v[1] = vn[1];
        }
    }
    for (int i = F.bid * 512 + F.tid; i < 65536; i += F.G * 512) cvt8(p.in[23] + (size_t)8 * i, (bf16_t*)(ws + WS_KEYS) + (size_t)8 * i);
}

template <int KW>
__device__ __forceinline__ void weights_to_i8(const Frame& F, const bf16_t* __restrict__ W, int N, unsigned char* __restrict__ W8, float* __restrict__ SB) {
    constexpr int NP = KW / 1024;
    for (int r = F.bid * 8 + F.wave; r < N; r += F.G * 8) {
        float v[NP][16]; float am = 0.f;
#pragma unroll
        for (int h = 0; h < NP; ++h) { const u32x4 a = *(const u32x4*)(W + (size_t)r * KW + 1024 * h + 16 * F.lane), b = *(const u32x4*)(W + (size_t)r * KW + 1024 * h + 16 * F.lane + 8);
#pragma unroll
            for (int i = 0; i < 4; ++i) { v[h][2 * i] = bf_lo(a[i]); v[h][2 * i + 1] = bf_hi(a[i]); v[h][8 + 2 * i] = bf_lo(b[i]); v[h][8 + 2 * i + 1] = bf_hi(b[i]); }
#pragma unroll
            for (int i = 0; i < 16; ++i) am = fmaxf(am, fabsf(v[h][i])); }
#pragma unroll
        for (int o = 32; o; o >>= 1) am = fmaxf(am, __shfl_xor(am, o));
        const float s = am > 0.f ? 127.f / am : 1.f;
#pragma unroll
        for (int h = 0; h < NP; ++h) { u32x4 o;
#pragma unroll
            for (int i = 0; i < 4; ++i) o[i] = pack_i8x4((f32x4){v[h][4 * i], v[h][4 * i + 1], v[h][4 * i + 2], v[h][4 * i + 3]}, s);
            *(u32x4*)(W8 + (size_t)r * KW + 1024 * h + 16 * F.lane) = o; }
        if (F.lane == 0) SB[r] = am > 0.f ? am * (1.f / 127.f) : 1.f;
    }
}
template <bool SRC_BF>
__device__ __forceinline__ void phase_norm(const Frame& F, const void* __restrict__ srcLv, const void* __restrict__ srcCv, int M, const float* __restrict__ w,
                                           const float* __restrict__ mod, int shift_off, int scale_off, bf16_t* __restrict__ H, unsigned char* __restrict__ H8 = nullptr, float* __restrict__ HS = nullptr,
                                           const bf16_t* __restrict__ POUT = nullptr, const float* __restrict__ pg5 = nullptr, bf16_t* __restrict__ RW = nullptr, unsigned char* __restrict__ Q8 = nullptr) {
    f32x4 wv4[4];
#pragma unroll
    for (int i = 0; i < 4; ++i) wv4[i] = *(const f32x4*)(w + 256 * i + 4 * F.lane);
    const int stride = F.G * 8;
    for (int row0 = F.bid * 8 + F.wave; row0 < M; row0 += 2 * stride) {
        f32x4 x[2][4]; u32x2 po[2][4]; f32x4 pg[2][4];
#pragma unroll
        for (int q = 0; q < 2; ++q) { const int row = row0 + q * stride;
            if (row < M) { const int j = row < ML ? (row >> 12) : 8;
#pragma unroll
                for (int i = 0; i < 4; ++i) { const int col = 256 * i + 4 * F.lane;
                    if (SRC_BF) { const u32x2 sv = *(const u32x2*)((const bf16_t*)srcLv + (size_t)row * 1024 + col); x[q][i] = (f32x4){bf_lo(sv[0]), bf_hi(sv[0]), bf_lo(sv[1]), bf_hi(sv[1])}; }
                    else { const float* sp = row < ML ? (const float*)srcLv + (size_t)row * 1024 : (const float*)srcCv + (size_t)(row - ML) * 1024; x[q][i] = *(const f32x4*)(sp + col); }
                    if (POUT) { pg[q][i] = *(const f32x4*)(pg5 + (size_t)j * 6144 + col); po[q][i] = *(const u32x2*)(POUT + (size_t)row * 1024 + col); } } } }
#pragma unroll
        for (int q = 0; q < 2; ++q) { const int row = row0 + q * stride;
            if (row < M) { const int j = row < ML ? (row >> 12) : 8; float ss = 0.f;
#pragma unroll
                for (int i = 0; i < 4; ++i) { const int col = 256 * i + 4 * F.lane;
                    if (POUT) { const f32x4 g5 = pg[q][i]; const u32x2 o = po[q][i];
                        x[q][i] = (f32x4){x[q][i][0] + g5[0] * bf_lo(o[0]), x[q][i][1] + g5[1] * bf_hi(o[0]), x[q][i][2] + g5[2] * bf_lo(o[1]), x[q][i][3] + g5[3] * bf_hi(o[1])};
                        *(u32x2*)(RW + (size_t)row * 1024 + col) = (u32x2){pk_bf16(x[q][i][0], x[q][i][1]), pk_bf16(x[q][i][2], x[q][i][3])}; }
                    ss += x[q][i][0] * x[q][i][0] + x[q][i][1] * x[q][i][1] + x[q][i][2] * x[q][i][2] + x[q][i][3] * x[q][i][3]; }
                ss = wave_sum(ss);
                const float rs = rsqrtf(ss * (1.f / 1024.f) + NORM_EPS);
                const float* mp = mod + (size_t)j * 6144;
                f32x4 h[4]; float am = 0.f;
#pragma unroll
                for (int i = 0; i < 4; ++i) { const int col = 256 * i + 4 * F.lane;
                    const f32x4 wv = wv4[i], sc = *(const f32x4*)(mp + scale_off + col), sh = *(const f32x4*)(mp + shift_off + col);
#pragma unroll
                    for (int e = 0; e < 4; ++e) { h[i][e] = x[q][i][e] * rs * wv[e] * (1.f + sc[e]) + sh[e]; am = fmaxf(am, fabsf(h[i][e])); }
                    if (H) *(u32x2*)(H + (size_t)row * 1024 + col) = (u32x2){pk_bf16(h[i][0], h[i][1]), pk_bf16(h[i][2], h[i][3])}; }
                if (H8) {
#pragma unroll
                    for (int o = 32; o; o >>= 1) am = fmaxf(am, __shfl_xor(am, o));
                    if (!H && !Q8) {
                        const float s7 = am > 0.f ? 127.f / am : 1.f;
#pragma unroll
                        for (int i = 0; i < 4; ++i) *(unsigned*)(H8 + (size_t)row * 1024 + 256 * i + 4 * F.lane) = pack_i8x4(h[i], s7);
                        if (F.lane == 0) HS[row] = am > 0.f ? am * (1.f / 127.f) : 1.f;
                        continue; }
                    const float s8 = am > 0.f ? 119.f / am : 1.f;
#pragma unroll
                    for (int i = 0; i < 4; ++i) { unsigned pa = 0, pb = 0;
#pragma unroll
                        for (int e = 0; e < 4; ++e) { const int q = max(-119, min(119, __float2int_rn(h[i][e] * s8))); const int a4 = (q + 8) >> 4, b4 = q - 16 * a4; pa |= ((unsigned)a4 & 15u) << (4 * e); pb |= ((unsigned)b4 & 15u) << (4 * e); }
                        *(u16*)(H8 + (size_t)row * 1024 + 256 * i + 2 * F.lane) = (u16)pa; *(u16*)(H8 + (size_t)row * 1024 + 256 * i + 128 + 2 * F.lane) = (u16)pb; }
                    if (Q8) {
#pragma unroll
                        for (int i = 0; i < 4; ++i) { unsigned w = 0;
#pragma unroll
                            for (int e = 0; e < 4; ++e) { const int q = max(-119, min(119, __float2int_rn(h[i][e] * s8))); w |= ((unsigned)q & 0xffu) << (8 * e); }
                            *(unsigned*)(Q8 + (size_t)row * 1024 + 256 * i + 4 * F.lane) = w; } }
                    if (F.lane == 0) HS[row] = am > 0.f ? am * (1.f / 119.f) : 1.f;
                } } }
    }
}

__device__ __forceinline__ u32x4 conv_row8(const u32x4& xm, const u32x4& x0, const u32x4& x1, const f32x4 (&w0)[2], const f32x4 (&w1)[2], const f32x4 (&w2)[2], const f32x4 (&bb)[2]) {
    float o[8];
#pragma unroll
    for (int e = 0; e < 8; ++e) { const int dw = e >> 1, hh = e >> 2, q = e & 3;
        const float a = (e & 1) ? bf_hi(xm[dw]) : bf_lo(xm[dw]), b = (e & 1) ? bf_hi(x0[dw]) : bf_lo(x0[dw]), c = (e & 1) ? bf_hi(x1[dw]) : bf_lo(x1[dw]);
        o[e] = silu_f(bb[hh][q] + w0[hh][q] * a + w1[hh][q] * b + w2[hh][q] * c); }
    return (u32x4){pk_bf16(o[0], o[1]), pk_bf16(o[2], o[3]), pk_bf16(o[4], o[5]), pk_bf16(o[6], o[7])};
}
__device__ __forceinline__ void phase_conv(const Frame& F, const Params& p) {
    bf16_t* X = (bf16_t*)(p.ws + WS_XBC);
    const float* cw = p.in[12]; const float* cb = p.in[13];
    for (int task = F.bid * 512 + F.tid; task < 512 * 256; task += F.G * 512) {
        const int seg = task >> 8, col = (task & 255) * 8;
        bf16_t* base = X + (size_t)seg * 64 * 2048 + col;
        f32x4 w0[2], w1[2], w2[2], bb[2];
#pragma unroll
        for (int hh = 0; hh < 2; ++hh) { w0[hh] = *(const f32x4*)(cw + col + 4 * hh); w1[hh] = *(const f32x4*)(cw + 2048 + col + 4 * hh); w2[hh] = *(const f32x4*)(cw + 4096 + col + 4 * hh); bb[hh] = *(const f32x4*)(cb + col + 4 * hh); }
        u32x4 prev = {0u, 0u, 0u, 0u}, cur = *(const u32x4*)base;
#pragma unroll 1
        for (int r0 = 0; r0 < 64; r0 += 8) {
            u32x4 nx[8];
#pragma unroll
            for (int k = 0; k < 8; ++k) { nx[k] = (u32x4){0u, 0u, 0u, 0u}; if (r0 + k + 1 < 64) nx[k] = *(const u32x4*)(base + (size_t)(r0 + k + 1) * 2048); }
#pragma unroll
            for (int k = 0; k < 8; ++k) { const u32x4 o = conv_row8(prev, cur, nx[k], w0, w1, w2, bb); *(u32x4*)(base + (size_t)(r0 + k) * 2048) = o; prev = cur; cur = nx[k]; }
        }
    }
    for (int u = F.bid; u < 512; u += F.G) {
        const int row0 = ML + (u >> 6) * 256, col0 = (u & 63) * 32;
        const int vc = F.tid & 3, ra = 2 * (F.tid >> 2), col = col0 + 8 * vc;
        bf16_t* base = X + (size_t)row0 * 2048 + col;
        u32x4 L[4];
#pragma unroll
        for (int q = 0; q < 4; ++q) { const int lr = ra - 1 + q; L[q] = (u32x4){0u, 0u, 0u, 0u}; if (lr >= 0 && lr < 256) L[q] = *(const u32x4*)(base + (size_t)lr * 2048); }
        f32x4 w0[2], w1[2], w2[2], bb[2];
#pragma unroll
        for (int hh = 0; hh < 2; ++hh) { w0[hh] = *(const f32x4*)(cw + col + 4 * hh); w1[hh] = *(const f32x4*)(cw + 2048 + col + 4 * hh); w2[hh] = *(const f32x4*)(cw + 4096 + col + 4 * hh); bb[hh] = *(const f32x4*)(cb + col + 4 * hh); }
        const u32x4 va = conv_row8(L[0], L[1], L[2], w0, w1, w2, bb), vb = conv_row8(L[1], L[2], L[3], w0, w1, w2, bb);
        __syncthreads();
        *(u32x4*)(base + (size_t)ra * 2048) = va; *(u32x4*)(base + (size_t)(ra + 1) * 2048) = vb;
    }
}

typedef short s16x4 __attribute__((ext_vector_type(4)));
__device__ __forceinline__ bf16x8 ld_row(LAS unsigned char* lds, int base, int stride, int rt, int ks, int lane) {
    return *(const LAS bf16x8*)(lds + base + (16 * rt + (lane & 15)) * stride + (32 * ks + 8 * (lane >> 4)) * 2);
}
__device__ __forceinline__ bf16x8 ld_tr(LAS unsigned char* lds, int base, int stride, int ks, int c0, int lane) {
    const int a = base + (32 * ks + 8 * (lane >> 4) + ((lane & 15) >> 2)) * stride + (c0 + 4 * (lane & 3)) * 2;
    const s16x4 lo = __builtin_amdgcn_ds_read_tr16_b64_v4i16((LAS s16x4*)(lds + a));
    const s16x4 hi = __builtin_amdgcn_ds_read_tr16_b64_v4i16((LAS s16x4*)(lds + a + 4 * stride));
    return (bf16x8){lo[0], lo[1], lo[2], lo[3], hi[0], hi[1], hi[2], hi[3]};
}
template <int CTRL, int RMASK, bool BC> __device__ __forceinline__ float dpp_get(float v) { return __int_as_float(__builtin_amdgcn_update_dpp(0, __float_as_int(v), CTRL, RMASK, 0xf, BC)); }
__device__ __forceinline__ float wave_incl_scan(float v) {
    v += dpp_get<0x111, 0xf, true>(v); v += dpp_get<0x112, 0xf, true>(v); v += dpp_get<0x114, 0xf, true>(v); v += dpp_get<0x118, 0xf, true>(v);
    v += dpp_get<0x142, 0xa, false>(v); v += dpp_get<0x143, 0xc, false>(v);
    return v;
}
__device__ __forceinline__ int chunk_row0(int q, int b, int d) { if (q < 4) { const int c = d ? 3 - q : q; return ML + b * 256 + 64 * c; } const int c = d ? 67 - q : q - 4; return b * 4096 + 64 * c; }
__device__ __forceinline__ float softplus_f(float x) { return fmaxf(x, 0.f) + __logf(1.f + __expf(-fabsf(x))); }
__device__ __forceinline__ u16 dw_elem(const u32x4& v, int e) { return (u16)((e & 1) ? (v[e >> 1] >> 16) : (v[e >> 1] & 0xffffu)); }

constexpr int SS_STR = 288, SS_XSTR = 144;
constexpr int SS_CM = 0, SS_BM = 64 * SS_STR, SS_X = 2 * 64 * SS_STR, SS_XE = SS_X + 64 * SS_XSTR, SS_SET = SS_XE + 64 * SS_XSTR;
constexpr int SS_ST = 2 * SS_SET, SS_GM = SS_ST + 2 * 16384, SS_LA = SS_GM + 4 * 2048, SS_LDT = SS_LA + 2 * 256, SS_END = SS_LDT + 2 * 256;
static_assert(SS_END <= LDS_MISC, "SSD LDS map");
struct SsdRegs { u32x4 cm[2], bm[2], xv; float dtr; };
__device__ __forceinline__ void ssd_load(SsdRegs& R, const bf16_t* __restrict__ XBC, const float* __restrict__ DT, int r0, int g, int h, int d, int tid, int lane) {
    const int cs0 = tid >> 4, ck8 = tid & 15, xs = tid >> 3, xp8 = tid & 7; const bf16_t* rp = XBC + (size_t)r0 * 2048;
#pragma unroll
    for (int i = 0; i < 2; ++i) { R.cm[i] = *(const u32x4*)(rp + (size_t)(cs0 + 32 * i) * 2048 + 1536 + g * 128 + ck8 * 8); R.bm[i] = *(const u32x4*)(rp + (size_t)(cs0 + 32 * i) * 2048 + 1024 + g * 128 + ck8 * 8); }
    R.xv = *(const u32x4*)(rp + (size_t)xs * 2048 + h * 64 + xp8 * 8); R.dtr = DT[(size_t)(r0 + lane) * 32 + d * 16 + h];
}
__device__ __forceinline__ float ssd_stage(LAS unsigned char* lds, const SsdRegs& R, int set, int d, float a, float bias, int tid, int lane, int wave) {
    const int cs0 = tid >> 4, ck8 = tid & 15, xs = tid >> 3, xp8 = tid & 7; const int sb = set * SS_SET;
    const float dt = softplus_f(R.dtr + bias), lg = dt * a;
    float la;
    if (d == 0) la = wave_incl_scan(lg);
    else { const float rv = __shfl(lg, 63 - lane); la = __shfl(wave_incl_scan(rv), 63 - lane); }
    const float la_end = __shfl(la, d ? 0 : 63);
    const float ee = __expf(la_end - la) * dt;
    if (wave == 0) { *(LAS float*)(lds + SS_LA + set * 256 + lane * 4) = la; *(LAS float*)(lds + SS_LDT + set * 256 + lane * 4) = dt; }
#pragma unroll
    for (int i = 0; i < 2; ++i) { const int s = cs0 + 32 * i;
        *(LAS u32x4*)(lds + sb + SS_CM + s * SS_STR + ck8 * 16) = R.cm[i]; *(LAS u32x4*)(lds + sb + SS_BM + s * SS_STR + ck8 * 16) = R.bm[i]; }
    const float ees = __shfl(ee, xs);
    *(LAS u32x4*)(lds + sb + SS_X + xs * SS_XSTR + xp8 * 16) = R.xv;
    u32x4 xe;
#pragma unroll
    for (int i = 0; i < 4; ++i) xe[i] = pk_bf16(bf_lo(R.xv[i]) * ees, bf_hi(R.xv[i]) * ees);
    *(LAS u32x4*)(lds + sb + SS_XE + xs * SS_XSTR + xp8 * 16) = xe;
    return __expf(la_end);
}
__device__ __forceinline__ void ssd_compute(LAS unsigned char* lds, int set, int d, float dsk, float dec, f32x4 (&S)[4], int r0, int h, bf16_t* YL, bf16_t* YC, int lane, int wave) {
    const int sb = set * SS_SET, fr = lane & 15, fq = lane >> 4, tt = wave >> 1, ph = wave & 1;
    bf16x8 cmf[4], bmf[4][4];
#pragma unroll
    for (int ks = 0; ks < 4; ++ks) cmf[ks] = ld_row(lds, sb + SS_CM, SS_STR, tt, ks, lane);
#pragma unroll
    for (int si = 0; si < 4; ++si)
#pragma unroll
        for (int ks = 0; ks < 4; ++ks) bmf[si][ks] = ld_row(lds, sb + SS_BM, SS_STR, si, ks, lane);
    const int t = 16 * tt + fr; const float lat = *(LAS float*)(lds + SS_LA + set * 256 + t * 4);
    f32x4 las[4], dts[4];
#pragma unroll
    for (int si = 0; si < 4; ++si) { las[si] = *(LAS f32x4*)(lds + SS_LA + set * 256 + (16 * si + 4 * fq) * 4); dts[si] = *(LAS f32x4*)(lds + SS_LDT + set * 256 + (16 * si + 4 * fq) * 4); }
    __builtin_amdgcn_sched_barrier(0);
    f32x4 gacc[4] = {{0.f, 0.f, 0.f, 0.f}, {0.f, 0.f, 0.f, 0.f}, {0.f, 0.f, 0.f, 0.f}, {0.f, 0.f, 0.f, 0.f}};
#pragma unroll
    for (int ks = 0; ks < 4; ++ks)
#pragma unroll
        for (int si = 0; si < 4; ++si) gacc[si] = mfma16(bmf[si][ks], cmf[ks], gacc[si]);
    bf16x8 stf[2][4], btf[2], xef[4][2];
#pragma unroll
    for (int ps = 0; ps < 2; ++ps)
#pragma unroll
        for (int ks = 0; ks < 4; ++ks) stf[ps][ks] = ld_frag(lds, SS_ST + set * 16384, 2 * ph + ps, ks, 4, lane);
#pragma unroll
    for (int ks = 0; ks < 2; ++ks) { btf[ks] = ld_tr(lds, sb + SS_BM, SS_STR, ks, 16 * wave, lane);
#pragma unroll
        for (int pt = 0; pt < 4; ++pt) xef[pt][ks] = ld_tr(lds, sb + SS_XE, SS_XSTR, ks, 16 * pt, lane); }
    __builtin_amdgcn_sched_barrier(0);
#pragma unroll
    for (int si = 0; si < 4; ++si) { const int s0 = 16 * si + 4 * fq; float v[4];
#pragma unroll
        for (int j = 0; j < 4; ++j) { const int s = s0 + j; const bool ok = d ? (s >= t) : (s <= t); v[j] = ok ? gacc[si][j] * __expf(lat - las[si][j]) * dts[si][j] : 0.f; if (s == t) v[j] += dsk; }
        *(LAS u32x2*)(lds + SS_GM + tt * 2048 + frag_off(fr, s0 >> 3, 2) + (s0 & 7) * 2) = (u32x2){pk_bf16(v[0], v[1]), pk_bf16(v[2], v[3])}; }
    f32x4 y2[2] = {{0.f, 0.f, 0.f, 0.f}, {0.f, 0.f, 0.f, 0.f}};
#pragma unroll
    for (int pt = 0; pt < 4; ++pt) S[pt] *= dec;
    __builtin_amdgcn_sched_barrier(0);
#pragma unroll
    for (int ks = 0; ks < 4; ++ks)
#pragma unroll
        for (int ps = 0; ps < 2; ++ps) y2[ps] = mfma16(stf[ps][ks], cmf[ks], y2[ps]);
#pragma unroll
    for (int ks = 0; ks < 2; ++ks)
#pragma unroll
        for (int pt = 0; pt < 4; ++pt) S[pt] = mfma16(btf[ks], xef[pt][ks], S[pt]);
    bf16x8 gmf[2], xtf[2][2];
#pragma unroll
    for (int ks = 0; ks < 2; ++ks) { gmf[ks] = ld_frag(lds, SS_GM + tt * 2048, 0, ks, 2, lane);
#pragma unroll
        for (int ps = 0; ps < 2; ++ps) xtf[ps][ks] = ld_tr(lds, sb + SS_X, SS_XSTR, ks, 16 * (2 * ph + ps), lane); }
    __builtin_amdgcn_sched_barrier(0);
    f32x4 y1[2] = {{0.f, 0.f, 0.f, 0.f}, {0.f, 0.f, 0.f, 0.f}};
#pragma unroll
    for (int ks = 0; ks < 2; ++ks)
#pragma unroll
        for (int ps = 0; ps < 2; ++ps) y1[ps] = mfma16(xtf[ps][ks], gmf[ks], y1[ps]);
    { const float sc = __expf(lat);
      bf16_t* yp = ((r0 >= ML) ? YC + (size_t)(r0 - ML + t) * 1024 : YL + (size_t)(r0 + t) * 1024) + ((h * 64 + (d ? 512 : 0)) & 1023) + 32 * ph + 4 * fq;
#pragma unroll
      for (int ps = 0; ps < 2; ++ps) *(u32x2*)(yp + 16 * ps) = (u32x2){pk_bf16(y1[ps][0] + sc * y2[ps][0], y1[ps][1] + sc * y2[ps][1]), pk_bf16(y1[ps][2] + sc * y2[ps][2], y1[ps][3] + sc * y2[ps][3])}; }
    { const int n0 = 16 * wave + 4 * fq;
#pragma unroll
      for (int pt = 0; pt < 4; ++pt) *(LAS u32x2*)(lds + SS_ST + (set ^ 1) * 16384 + frag_off(16 * pt + fr, n0 >> 3, 4) + (n0 & 7) * 2) = (u32x2){pk_bf16(S[pt][0], S[pt][1]), pk_bf16(S[pt][2], S[pt][3])}; }
}
__device__ __forceinline__ void phase_ssd(const Frame& F, const Params& p) {
    LAS unsigned char* lds = F.lds;
    const bf16_t* XBC = (const bf16_t*)(p.ws + WS_XBC); const float* DT = (const float*)(p.ws + WS_DT);
    const int tid = F.tid, lane = F.lane, wave = F.wave, fr = lane & 15, fq = lane >> 4;
    const int tt = wave >> 1, ph = wave & 1;
    for (int u0 = F.bid; u0 < 256; u0 += F.G) {
        const int u = (((u0 & 7) * 4 + (u0 >> 6)) << 3) | ((u0 >> 3) & 7);
        const int b = u >> 5, h = (u >> 1) & 15, d = u & 1, g = h >> 2;
        const float a = -__expf(p.in[15][d * 16 + h]), bias = p.in[14][d * 16 + h], dsk = d == 0 ? p.in[16][h] : 0.f;
        bf16_t* YL = (bf16_t*)((unsigned char*)p.out + (d ? DO_Y1 : 0)); bf16_t* YC = (bf16_t*)(p.ws + WS_YC) + (size_t)d * 2048 * 1024;
        for (int i = tid; i < 1024; i += 512) *(LAS u32x4*)(lds + SS_ST + i * 16) = (u32x4){0u, 0u, 0u, 0u};
        f32x4 S[4];
#pragma unroll
        for (int i = 0; i < 4; ++i) S[i] = (f32x4){0.f, 0.f, 0.f, 0.f};
        SsdRegs R;
        ssd_load(R, XBC, DT, chunk_row0(0, b, d), g, h, d, tid, lane);
        float dec_next = ssd_stage(lds, R, 0, d, a, bias, tid, lane, wave);
        ssd_load(R, XBC, DT, chunk_row0(1, b, d), g, h, d, tid, lane);
        __syncthreads();
        for (int q = 0; q < 68; ++q) {
            const int set = q & 1, sb = set * SS_SET, r0 = chunk_row0(q, b, d);
            const float dec = dec_next;
            if (q + 1 < 68) dec_next = ssd_stage(lds, R, set ^ 1, d, a, bias, tid, lane, wave);
            if (q + 2 < 68) ssd_load(R, XBC, DT, chunk_row0(q + 2, b, d), g, h, d, tid, lane);
            ssd_compute(lds, set, d, dsk, dec, S, r0, h, YL, YC, lane, wave);
            __syncthreads();
        }
    }
}

__device__ __forceinline__ void phase_finish0(const Frame& F, const Params& p, int row_first, int row_end, int row_stride) {
    const bf16_t* P4 = (const bf16_t*)(p.ws + WS_P4); bf16_t* A2 = (bf16_t*)(p.ws + WS_A2);
    const bf16_t* YL0 = (const bf16_t*)p.out; const bf16_t* YL1 = (const bf16_t*)((const unsigned char*)p.out + DO_Y1);
    const bf16_t* YC0 = (const bf16_t*)(p.ws + WS_YC); const bf16_t* YC1 = YC0 + (size_t)2048 * 1024;
    const int c0 = F.lane * 16;
    f32x4 w0[4], w1[4], w2[4], gn[4];
#pragma unroll
    for (int q = 0; q < 4; ++q) { w0[q] = *(const f32x4*)(p.in[11] + c0 + 4 * q); w1[q] = *(const f32x4*)(p.in[11] + 1024 + c0 + 4 * q); w2[q] = *(const f32x4*)(p.in[11] + 2048 + c0 + 4 * q); gn[q] = *(const f32x4*)(p.in[17] + c0 + 4 * q); }
    for (int row = row_first; row < row_end; row += row_stride) {
        bool hp, hn;
        if (row < ML) { const int lr = row & 63; hp = lr > 0; hn = lr < 63; } else { const int lr = (row - ML) & 255; hp = lr > 0; hn = lr < 255; }
        const bf16_t* pr = P4 + (size_t)row * 3072 + c0;
        u32x4 pc[2], pp[2], pn[2], sb[2], sz[2], y0[2], y1[2];
        const bf16_t* y0p = row < ML ? YL0 + (size_t)row * 1024 + c0 : YC0 + (size_t)(row - ML) * 1024 + c0;
        const bf16_t* y1p = (row < ML ? YL1 + (size_t)row * 1024 : YC1 + (size_t)(row - ML) * 1024) + ((c0 + 512) & 1023);
#pragma unroll
        for (int i = 0; i < 2; ++i) { pc[i] = *(const u32x4*)(pr + 8 * i); sb[i] = *(const u32x4*)(pr + 1024 + 8 * i); sz[i] = *(const u32x4*)(pr + 2048 + 8 * i);
            pp[i] = (u32x4){0u, 0u, 0u, 0u}; pn[i] = (u32x4){0u, 0u, 0u, 0u};
            if (hp) pp[i] = *(const u32x4*)(pr - 3072 + 8 * i);
            if (hn) pn[i] = *(const u32x4*)(pr + 3072 + 8 * i);
            y0[i] = *(const u32x4*)(y0p + 8 * i); y1[i] = *(const u32x4*)(y1p + 8 * i); }
        float ya[16], yb[16]; float ss = 0.f;
#pragma unroll
        for (int i = 0; i < 2; ++i)
#pragma unroll
            for (int q = 0; q < 2; ++q) { const int wq = 2 * i + q;
#pragma unroll
                for (int e = 0; e < 4; ++e) { const int dw = 2 * q + (e >> 1), o = 8 * i + 4 * q + e;
                    const float xp = (e & 1) ? bf_hi(pp[i][dw]) : bf_lo(pp[i][dw]), xc = (e & 1) ? bf_hi(pc[i][dw]) : bf_lo(pc[i][dw]), xn = (e & 1) ? bf_hi(pn[i][dw]) : bf_lo(pn[i][dw]);
                    const float bv = (e & 1) ? bf_hi(sb[i][dw]) : bf_lo(sb[i][dw]), zv = (e & 1) ? bf_hi(sz[i][dw]) : bf_lo(sz[i][dw]);
                    const float ya0 = (e & 1) ? bf_hi(y0[i][dw]) : bf_lo(y0[i][dw]), ya1 = (e & 1) ? bf_hi(y1[i][dw]) : bf_lo(y1[i][dw]);
                    ya[o] = bv * (w0[wq][e] * xp + w1[wq][e] * xc + w2[wq][e] * xn);
                    const float v = (ya0 + ya1) * zv; yb[o] = v; ss += v * v; } }
        ss += __shfl_xor(ss, 1); ss += __shfl_xor(ss, 2); ss += __shfl_xor(ss, 4); ss += __shfl_xor(ss, 8);
        const float rs = rsqrtf(ss * (1.f / 256.f) + NORM_EPS);
        float am = 0.f;
#pragma unroll
        for (int i = 0; i < 2; ++i) { const f32x4 g0 = gn[2 * i], g1 = gn[2 * i + 1];
#pragma unroll
            for (int e = 0; e < 4; ++e) { yb[8 * i + e] *= rs * g0[e]; yb[8 * i + 4 + e] *= rs * g1[e]; } }
#pragma unroll
        for (int o = 0; o < 16; ++o) am = fmaxf(am, fmaxf(fabsf(ya[o]), fabsf(yb[o])));
#pragma unroll
        for (int o = 32; o; o >>= 1) am = fmaxf(am, __shfl_xor(am, o));
        const float s7 = am > 0.f ? 127.f / am : 1.f;
        unsigned char* ap = (unsigned char*)A2 + (size_t)row * 2048 + c0;
        u32x4 oa, ob;
#pragma unroll
        for (int i = 0; i < 4; ++i) { oa[i] = pack_i8x4((f32x4){ya[4 * i], ya[4 * i + 1], ya[4 * i + 2], ya[4 * i + 3]}, s7); ob[i] = pack_i8x4((f32x4){yb[4 * i], yb[4 * i + 1], yb[4 * i + 2], yb[4 * i + 3]}, s7); }
        *(u32x4*)ap = oa; *(u32x4*)(ap + 1024) = ob;
        if (F.lane == 0) ((float*)(p.ws + WS_AS2))[row] = am > 0.f ? am * (1.f / 127.f) : 1.f;
    }
}

__device__ __forceinline__ int enc_key(float s) { const int b = __float_as_int(s); return b ^ ((b >> 31) & 0x7fffffff); }
__device__ __forceinline__ float dec_key(int k) { return __int_as_float(k ^ ((k >> 31) & 0x7fffffff)); }
__device__ __forceinline__ int med3i(int a, int b, int c) { return max(min(a, b), min(max(a, b), c)); }
#define TK_INSERT(L, v) do { _Pragma("unroll") for (int _i = 15; _i > 0; --_i) L[_i] = med3i(L[_i - 1], L[_i], (v)); L[0] = max(L[0], (v)); } while (0)
__device__ __forceinline__ void tk_merge(int (&L)[16], int xr) {
    int P[16];
#pragma unroll
    for (int i = 0; i < 16; ++i) P[i] = __shfl_xor(L[i], xr);
#pragma unroll
    for (int i = 0; i < 16; ++i) L[i] = max(L[i], P[15 - i]);
#pragma unroll
    for (int st = 8; st > 0; st >>= 1)
#pragma unroll
        for (int i = 0; i < 16; ++i) if ((i & st) == 0) { const int a = L[i], b = L[i + st]; L[i] = max(a, b); L[i + st] = min(a, b); }
}
__device__ __forceinline__ void tk_top16(int (&L)[16], const int (&P)[16]) {
#pragma unroll
    for (int i = 0; i < 16; ++i) L[i] = max(L[i], P[15 - i]);
#pragma unroll
    for (int st = 8; st > 0; st >>= 1)
#pragma unroll
        for (int i = 0; i < 16; ++i) if ((i & st) == 0) { const int a = L[i], b = L[i + st]; L[i] = max(a, b); L[i + st] = min(a, b); }
}
constexpr int TK_Q = 0, TK_K = 65536;
#define TK_CE(L, i, j) do { const int _a = L[i], _b = L[j]; L[i] = max(_a, _b); L[j] = min(_a, _b); } while (0)
__device__ __forceinline__ void topk_half(LAS unsigned char* lds, int a, const u32x4 (&qf)[8], int lane, int (&L)[16]) {
    const int fq = lane >> 4;
    int M[16];
    bf16x8 bq[4];
#pragma unroll
    for (int ks = 0; ks < 4; ++ks) bq[ks] = __builtin_bit_cast(bf16x8, qf[a * 4 + ks]);
    f32x4 accn[2] = {{0.f, 0.f, 0.f, 0.f}, {0.f, 0.f, 0.f, 0.f}};
    { bf16x8 kf[2][4];
#pragma unroll
      for (int n = 0; n < 2; ++n)
#pragma unroll
          for (int ks = 0; ks < 4; ++ks) kf[n][ks] = ld_frag(lds, TK_K, a * 8 + n, ks, 4, lane);
      __builtin_amdgcn_sched_barrier(0);
#pragma unroll
      for (int ks = 0; ks < 4; ++ks)
#pragma unroll
          for (int n = 0; n < 2; ++n) accn[n] = mfma16(kf[n][ks], bq[ks], accn[n]); }
#pragma unroll
    for (int nh = 0; nh < 4; ++nh) {
        f32x4 acc[2] = {accn[0], accn[1]};
        if (nh < 3) { bf16x8 kf[2][4];
#pragma unroll
            for (int n = 0; n < 2; ++n)
#pragma unroll
                for (int ks = 0; ks < 4; ++ks) kf[n][ks] = ld_frag(lds, TK_K, a * 8 + 2 * (nh + 1) + n, ks, 4, lane);
            __builtin_amdgcn_sched_barrier(0);
            accn[0] = (f32x4){0.f, 0.f, 0.f, 0.f}; accn[1] = (f32x4){0.f, 0.f, 0.f, 0.f};
#pragma unroll
            for (int ks = 0; ks < 4; ++ks)
#pragma unroll
                for (int n = 0; n < 2; ++n) accn[n] = mfma16(kf[n][ks], bq[ks], accn[n]); }
#pragma unroll
        for (int n = 0; n < 2; ++n)
#pragma unroll
            for (int j = 0; j < 4; ++j) { const int key = (enc_key(acc[n][j]) & ~127) | (16 * (2 * nh + n) + 4 * fq + j); if (nh < 2) L[8 * nh + 4 * n + j] = key; else M[8 * (nh - 2) + 4 * n + j] = key; }
        if (nh == 1) { TK_CE(L, 0, 1); TK_CE(L, 2, 3); TK_CE(L, 0, 2); TK_CE(L, 1, 3); TK_CE(L, 1, 2); TK_CE(L, 4, 5); TK_CE(L, 6, 7); TK_CE(L, 4, 6); TK_CE(L, 5, 7); TK_CE(L, 5, 6); TK_CE(L, 0, 4); TK_CE(L, 2, 6); TK_CE(L, 2, 4); TK_CE(L, 1, 5); TK_CE(L, 3, 7); TK_CE(L, 3, 5); TK_CE(L, 1, 2); TK_CE(L, 3, 4); TK_CE(L, 5, 6); TK_CE(L, 8, 9); TK_CE(L, 10, 11); TK_CE(L, 8, 10); TK_CE(L, 9, 11); TK_CE(L, 9, 10); TK_CE(L, 12, 13); TK_CE(L, 14, 15); TK_CE(L, 12, 14); TK_CE(L, 13, 15); TK_CE(L, 13, 14); TK_CE(L, 8, 12); TK_CE(L, 10, 14); TK_CE(L, 10, 12); TK_CE(L, 9, 13); TK_CE(L, 11, 15); TK_CE(L, 11, 13); TK_CE(L, 9, 10); TK_CE(L, 11, 12); TK_CE(L, 13, 14); TK_CE(L, 0, 8); TK_CE(L, 4, 12); TK_CE(L, 4, 8); TK_CE(L, 2, 10); TK_CE(L, 6, 14); TK_CE(L, 6, 10); TK_CE(L, 2, 4); TK_CE(L, 6, 8); TK_CE(L, 10, 12); TK_CE(L, 1, 9); TK_CE(L, 5, 13); TK_CE(L, 5, 9); TK_CE(L, 3, 11); TK_CE(L, 7, 15); TK_CE(L, 7, 11); TK_CE(L, 3, 5); TK_CE(L, 7, 9); TK_CE(L, 11, 13); TK_CE(L, 1, 2); TK_CE(L, 3, 4); TK_CE(L, 5, 6); TK_CE(L, 7, 8); TK_CE(L, 9, 10); TK_CE(L, 11, 12); TK_CE(L, 13, 14); }
        if (nh == 3) { TK_CE(M, 0, 1); TK_CE(M, 2, 3); TK_CE(M, 0, 2); TK_CE(M, 1, 3); TK_CE(M, 1, 2); TK_CE(M, 4, 5); TK_CE(M, 6, 7); TK_CE(M, 4, 6); TK_CE(M, 5, 7); TK_CE(M, 5, 6); TK_CE(M, 0, 4); TK_CE(M, 2, 6); TK_CE(M, 2, 4); TK_CE(M, 1, 5); TK_CE(M, 3, 7); TK_CE(M, 3, 5); TK_CE(M, 1, 2); TK_CE(M, 3, 4); TK_CE(M, 5, 6); TK_CE(M, 8, 9); TK_CE(M, 10, 11); TK_CE(M, 8, 10); TK_CE(M, 9, 11); TK_CE(M, 9, 10); TK_CE(M, 12, 13); TK_CE(M, 14, 15); TK_CE(M, 12, 14); TK_CE(M, 13, 15); TK_CE(M, 13, 14); TK_CE(M, 8, 12); TK_CE(M, 10, 14); TK_CE(M, 10, 12); TK_CE(M, 9, 13); TK_CE(M, 11, 15); TK_CE(M, 11, 13); TK_CE(M, 9, 10); TK_CE(M, 11, 12); TK_CE(M, 13, 14); TK_CE(M, 0, 8); TK_CE(M, 4, 12); TK_CE(M, 4, 8); TK_CE(M, 2, 10); TK_CE(M, 6, 14); TK_CE(M, 6, 10); TK_CE(M, 2, 4); TK_CE(M, 6, 8); TK_CE(M, 10, 12); TK_CE(M, 1, 9); TK_CE(M, 5, 13); TK_CE(M, 5, 9); TK_CE(M, 3, 11); TK_CE(M, 7, 15); TK_CE(M, 7, 11); TK_CE(M, 3, 5); TK_CE(M, 7, 9); TK_CE(M, 11, 13); TK_CE(M, 1, 2); TK_CE(M, 3, 4); TK_CE(M, 5, 6); TK_CE(M, 7, 8); TK_CE(M, 9, 10); TK_CE(M, 11, 12); TK_CE(M, 13, 14); }
    }
    tk_top16(L, M);
    tk_merge(L, 16); tk_merge(L, 32);
}
__device__ __forceinline__ unsigned tk_lookup(const unsigned (&P)[4], int i) {
    const unsigned long long lo = (unsigned long long)P[0] | ((unsigned long long)P[1] << 32), hi = (unsigned long long)P[2] | ((unsigned long long)P[3] << 32);
    const unsigned long long h = (i & 8) ? hi : lo;
    return (unsigned)(h >> ((i & 7) * 8)) & 127u;
}
__device__ __forceinline__ void phase_topk(const Frame& F, const Params& p, int layer, const bf16_t* __restrict__ Q, int M, u16* __restrict__ IDX, float* __restrict__ GATE, float* __restrict__ SUA) {
    LAS unsigned char* lds = F.lds;
    const unsigned char* tabb = p.ws + (layer ? WS_TAB1 : WS_TAB);
    const float* SCU = (const float*)(tabb + TAB_SCU); const float* SCV = (const float*)(tabb + TAB_SCV);
    const bf16_t* KEYS = (const bf16_t*)(p.ws + WS_KEYS) + (size_t)layer * 8 * 2 * 128 * 128;
    const int tid = F.tid, lane = F.lane, wave = F.wave, fr = lane & 15, fq = lane >> 4;
    const int nunits = (M >> 7) * 8;
    int head_staged = -1;
    float pend_su[4], pend_sv[4], pend_gt[4]; size_t pend_o = 0; bool pend_valid = false;
#pragma unroll
    for (int kk = 0; kk < 4; ++kk) { pend_su[kk] = 0.f; pend_sv[kk] = 0.f; pend_gt[kk] = 0.f; }
    u32x4 qpre[8];
    if (F.bid < nunits) {
#pragma unroll
        for (int ks = 0; ks < 8; ++ks) qpre[ks] = *(const u32x4*)(Q + (size_t)((F.bid >> 3) * 128 + 16 * wave + fr) * 2048 + (F.bid & 7) * 256 + 32 * ks + 8 * fq);
    }
    for (int u = F.bid; u < nunits; u += F.G) {
        const int head = u & 7, row0 = (u >> 3) * 128;
        if (head != head_staged) {
            __syncthreads();
#pragma unroll
            for (int i = 0; i < 8; ++i) { const int o = tid + 512 * i, r = o >> 4, k8 = o & 15;
                *(LAS u32x4*)(lds + TK_K + frag_off(r, k8, 4)) = *(const u32x4*)(KEYS + (size_t)(head * 256 + r) * 128 + k8 * 8); }
            head_staged = head;
            __syncthreads();
        }
        u32x4 qf[8];
#pragma unroll
        for (int ks = 0; ks < 8; ++ks) qf[ks] = qpre[ks];
        { const int un = u + F.G;
          if (un < nunits) {
#pragma unroll
              for (int ks = 0; ks < 8; ++ks) qpre[ks] = *(const u32x4*)(Q + (size_t)((un >> 3) * 128 + 16 * wave + fr) * 2048 + (un & 7) * 256 + 32 * ks + 8 * fq); } }
        int L0[16], L1[16];
        topk_half(lds, 0, qf, lane, L0);
        topk_half(lds, 1, qf, lane, L1);
        float f0[16], f1[16];
#pragma unroll
        for (int i = 0; i < 16; ++i) { f0[i] = dec_key(L0[i] & ~127); f1[i] = dec_key(L1[i] & ~127); }
        int C[16];
#pragma unroll
        for (int i = 0; i < 16; ++i) C[i] = (int)0x80000000;
        const bool b0 = (fq & 1) != 0, b1 = (fq & 2) != 0;
        { const float sa_ = f0[0], sb_ = (b1 ? (b0 ? f1[3] : f1[2]) : (b0 ? f1[1] : f1[0])); const int pay = (b1 ? (b0 ? 3 : 2) : (b0 ? 1 : 0)); C[0] = (enc_key(sa_ + sb_) & ~255) | pay; }
        { const float sa_ = f0[0], sb_ = (b1 ? (b0 ? f1[7] : f1[6]) : (b0 ? f1[5] : f1[4])); const int pay = (b1 ? (b0 ? 7 : 6) : (b0 ? 5 : 4)); C[1] = (enc_key(sa_ + sb_) & ~255) | pay; }
        { const float sa_ = f0[0], sb_ = (b1 ? (b0 ? f1[11] : f1[10]) : (b0 ? f1[9] : f1[8])); const int pay = (b1 ? (b0 ? 11 : 10) : (b0 ? 9 : 8)); C[2] = (enc_key(sa_ + sb_) & ~255) | pay; }
        { const float sa_ = f0[0], sb_ = (b1 ? (b0 ? f1[15] : f1[14]) : (b0 ? f1[13] : f1[12])); const int pay = (b1 ? (b0 ? 15 : 14) : (b0 ? 13 : 12)); C[3] = (enc_key(sa_ + sb_) & ~255) | pay; }
        { const float sa_ = f0[1], sb_ = (b1 ? (b0 ? f1[3] : f1[2]) : (b0 ? f1[1] : f1[0])); const int pay = (b1 ? (b0 ? 19 : 18) : (b0 ? 17 : 16)); C[4] = (enc_key(sa_ + sb_) & ~255) | pay; }
        { const float sa_ = f0[1], sb_ = (b1 ? (b0 ? f1[7] : f1[6]) : (b0 ? f1[5] : f1[4])); const int pay = (b1 ? (b0 ? 23 : 22) : (b0 ? 21 : 20)); C[5] = (enc_key(sa_ + sb_) & ~255) | pay; }
        { const float sa_ = f0[2], sb_ = (b1 ? (b0 ? f1[3] : f1[2]) : (b0 ? f1[1] : f1[0])); const int pay = (b1 ? (b0 ? 35 : 34) : (b0 ? 33 : 32)); C[6] = (enc_key(sa_ + sb_) & ~255) | pay; }
        { const float sa_ = (b1 ? f0[3] : (b0 ? f0[3] : f0[2])), sb_ = (b1 ? (b0 ? f1[2] : f1[1]) : (b0 ? f1[0] : f1[4])); const int pay = (b1 ? (b0 ? 50 : 49) : (b0 ? 48 : 36)); C[7] = (enc_key(sa_ + sb_) & ~255) | pay; }
        { const float sa_ = (b1 ? f0[4] : (b0 ? f0[4] : f0[3])), sb_ = (b1 ? (b0 ? f1[2] : f1[1]) : (b0 ? f1[0] : f1[3])); const int pay = (b1 ? (b0 ? 66 : 65) : (b0 ? 64 : 51)); C[8] = (enc_key(sa_ + sb_) & ~255) | pay; }
        { const float sa_ = (b1 ? f0[6] : f0[5]), sb_ = (b0 ? f1[1] : f1[0]); const int pay = (b1 ? (b0 ? 97 : 96) : (b0 ? 81 : 80)); C[9] = (enc_key(sa_ + sb_) & ~255) | pay; }
        { const float sa_ = (b1 ? (b0 ? f0[9] : f0[8]) : f0[7]), sb_ = (b1 ? f1[0] : (b0 ? f1[1] : f1[0])); const int pay = (b1 ? (b0 ? 144 : 128) : (b0 ? 113 : 112)); C[10] = (enc_key(sa_ + sb_) & ~255) | pay; }
        { const float sa_ = (b1 ? (b0 ? f0[13] : f0[12]) : (b0 ? f0[11] : f0[10])), sb_ = f1[0]; const int pay = (b1 ? (b0 ? 208 : 192) : (b0 ? 176 : 160)); C[11] = (enc_key(sa_ + sb_) & ~255) | pay; }
        { const float sa_ = (b1 ? -3.0e38f : (b0 ? f0[15] : f0[14])), sb_ = (b1 ? 0.f : f1[0]); const int pay = (b1 ? 0 : (b0 ? 240 : 224)); C[12] = (enc_key(sa_ + sb_) & ~255) | pay; }
        { TK_CE(C, 0, 1); TK_CE(C, 2, 3); TK_CE(C, 0, 2); TK_CE(C, 1, 3); TK_CE(C, 1, 2); TK_CE(C, 4, 5); TK_CE(C, 6, 7); TK_CE(C, 4, 6); TK_CE(C, 5, 7); TK_CE(C, 5, 6); TK_CE(C, 0, 4); TK_CE(C, 2, 6); TK_CE(C, 2, 4); TK_CE(C, 1, 5); TK_CE(C, 3, 7); TK_CE(C, 3, 5); TK_CE(C, 1, 2); TK_CE(C, 3, 4); TK_CE(C, 5, 6); TK_CE(C, 8, 9); TK_CE(C, 10, 11); TK_CE(C, 8, 10); TK_CE(C, 9, 11); TK_CE(C, 9, 10); TK_CE(C, 12, 13); TK_CE(C, 14, 15); TK_CE(C, 12, 14); TK_CE(C, 13, 15); TK_CE(C, 13, 14); TK_CE(C, 8, 12); TK_CE(C, 10, 14); TK_CE(C, 10, 12); TK_CE(C, 9, 13); TK_CE(C, 11, 15); TK_CE(C, 11, 13); TK_CE(C, 9, 10); TK_CE(C, 11, 12); TK_CE(C, 13, 14); TK_CE(C, 0, 8); TK_CE(C, 4, 12); TK_CE(C, 4, 8); TK_CE(C, 2, 10); TK_CE(C, 6, 14); TK_CE(C, 6, 10); TK_CE(C, 2, 4); TK_CE(C, 6, 8); TK_CE(C, 10, 12); TK_CE(C, 1, 9); TK_CE(C, 5, 13); TK_CE(C, 5, 9); TK_CE(C, 3, 11); TK_CE(C, 7, 15); TK_CE(C, 7, 11); TK_CE(C, 3, 5); TK_CE(C, 7, 9); TK_CE(C, 11, 13); TK_CE(C, 1, 2); TK_CE(C, 3, 4); TK_CE(C, 5, 6); TK_CE(C, 7, 8); TK_CE(C, 9, 10); TK_CE(C, 11, 12); TK_CE(C, 13, 14); }
        tk_merge(C, 16); tk_merge(C, 32);
        unsigned P0[4], P1[4];
#pragma unroll
        for (int q = 0; q < 4; ++q) { P0[q] = (unsigned)(L0[4 * q] & 127) | ((unsigned)(L0[4 * q + 1] & 127) << 8) | ((unsigned)(L0[4 * q + 2] & 127) << 16) | ((unsigned)(L0[4 * q + 3] & 127) << 24);
                                      P1[q] = (unsigned)(L1[4 * q] & 127) | ((unsigned)(L1[4 * q + 1] & 127) << 8) | ((unsigned)(L1[4 * q + 2] & 127) << 16) | ((unsigned)(L1[4 * q + 3] & 127) << 24); }
        const float mx = dec_key(C[0] & ~255);
        float sum = 0.f;
#pragma unroll
        for (int k = 0; k < 16; ++k) sum += __expf(dec_key(C[k] & ~255) - mx);
        const float inv = 1.f / sum;
        unsigned eidx[4]; float gt[4];
#pragma unroll
        for (int kk = 0; kk < 4; ++kk) { const int ck = fq == 0 ? C[kk] : (fq == 1 ? C[4 + kk] : (fq == 2 ? C[8 + kk] : C[12 + kk]));
            gt[kk] = __expf(dec_key(ck & ~255) - mx) * inv; const int pos = ck & 255; eidx[kk] = tk_lookup(P0, pos >> 4) * 128u + tk_lookup(P1, pos & 15); }
        if (pend_valid) { const size_t o = pend_o;
            *(f32x4*)(GATE + o) = (f32x4){pend_gt[0] * pend_sv[0], pend_gt[1] * pend_sv[1], pend_gt[2] * pend_sv[2], pend_gt[3] * pend_sv[3]};
            *(f32x4*)(SUA + o) = (f32x4){pend_su[0], pend_su[1], pend_su[2], pend_su[3]}; }
        { const size_t o = (size_t)(row0 + 16 * wave + fr) * 128 + head * 16 + 4 * fq;
          *(u32x2*)(IDX + o) = (u32x2){eidx[0] | (eidx[1] << 16), eidx[2] | (eidx[3] << 16)};
#pragma unroll
          for (int kk = 0; kk < 4; ++kk) { pend_su[kk] = SCU[eidx[kk]]; pend_sv[kk] = SCV[eidx[kk]]; pend_gt[kk] = gt[kk]; }
          pend_o = o; pend_valid = true; }
    }
    if (pend_valid) { const size_t o = pend_o;
        *(f32x4*)(GATE + o) = (f32x4){pend_gt[0] * pend_sv[0], pend_gt[1] * pend_sv[1], pend_gt[2] * pend_sv[2], pend_gt[3] * pend_sv[3]};
        *(f32x4*)(SUA + o) = (f32x4){pend_su[0], pend_su[1], pend_su[2], pend_su[3]}; }
    __syncthreads();
}

constexpr size_t WS_QUEUE = 16384;
__device__ __forceinline__ int q_next(const Frame& F, unsigned* head, int pending_valid, int& pending) {
    volatile LAS int* w = (volatile LAS int*)(F.lds + LDS_MISC + 64);
    if (F.tid == 0) { *w = pending_valid ? pending : (int)__hip_atomic_fetch_add(head, 1u, __ATOMIC_RELAXED, __HIP_MEMORY_SCOPE_AGENT); }
    __syncthreads();
    const int v = *w;
    __syncthreads();
    if (F.tid == 0) pending = (int)__hip_atomic_fetch_add(head, 1u, __ATOMIC_RELAXED, __HIP_MEMORY_SCOPE_AGENT);
    return v;
}
constexpr int PEER_TOK = 8;
__device__ __forceinline__ void g1_issue(u32x4 (&uu)[16], int id0, int id1, __amdgpu_buffer_rsrc_t rs, int coff, int g) {
#pragma unroll
    for (int L = 0; L < 16; ++L) { const int eid = __shfl(L < 8 ? id0 : id1, (8 * L + g) & 63); uu[L] = __builtin_amdgcn_raw_buffer_load_b128(rs, eid * 128 + coff, 0, 0); }
}
__device__ __forceinline__ void g1i_compute(const u32x4 (&uu)[16], const u32x4& ha, const u32x4& hb, int c, bf16_t* __restrict__ dst) {
    int pv[16];
#pragma unroll
    for (int L = 0; L < 16; ++L) { int a = 0, b = 0;
#pragma unroll
        for (int i = 0; i < 4; ++i) { a = __builtin_amdgcn_sdot8((int)uu[L][i], (int)ha[i], a, false); b = __builtin_amdgcn_sdot8((int)uu[L][i], (int)hb[i], b, false); }
        pv[L] = 16 * a + b; }
    int r8[8], r4[4], r2[2];
    { const bool hi = (c & 1) != 0;
#pragma unroll
      for (int i = 0; i < 8; ++i) { const int send = hi ? pv[i] : pv[8 + i], keep = hi ? pv[8 + i] : pv[i]; r8[i] = keep + __shfl_xor(send, 1); } }
    { const bool hi = (c & 2) != 0;
#pragma unroll
      for (int i = 0; i < 4; ++i) { const int send = hi ? r8[i] : r8[4 + i], keep = hi ? r8[4 + i] : r8[i]; r4[i] = keep + __shfl_xor(send, 2); } }
    { const bool hi = (c & 4) != 0;
#pragma unroll
      for (int i = 0; i < 2; ++i) { const int send = hi ? r4[i] : r4[2 + i], keep = hi ? r4[2 + i] : r4[i]; r2[i] = keep + __shfl_xor(send, 4); } }
    __builtin_nontemporal_store(pk_bf16((float)r2[0], (float)r2[1]), (unsigned*)dst);
}
__device__ __forceinline__ void phase_peer_g1i(const Frame& F, const Params& p, const unsigned char* __restrict__ H8, const u16* __restrict__ IDX, bf16_t* PART, int M, int qslot) {
    const unsigned char* U4 = p.ws + ((qslot & 2) ? WS_TAB1 : WS_TAB);
    unsigned* heads = (unsigned*)(p.ws + WS_CTL + WS_QUEUE) + (size_t)qslot * 8 * 64;
    const int nitems = M / (8 * PEER_TOK), myx = (int)(xb_xcc_id() & 3u), lane = F.lane, g = lane >> 3, c = lane & 7;
    for (int k = 0; k < 4; ++k) { const int x = (myx + k) & 3; bf16_t* PARTx = PART + (size_t)x * M * 128;
        const __amdgpu_buffer_rsrc_t Ux = __builtin_amdgcn_make_buffer_rsrc((void*)(U4 + (size_t)x * TAB_SLICE), 0, (int)TAB_SLICE, 0x00020000); const int coff = 16 * c; int pending = 0, pv = 0;
        for (;;) { const int item = q_next(F, heads + x * 64, pv, pending); pv = 1; if (item >= nitems) break;
            const int t0 = item * 8 * PEER_TOK + F.wave;
            int id0[2], id1[2]; u32x4 ha[2], hb[2], uu[2][16];
#pragma unroll
            for (int r = 0; r < 2; ++r) { const size_t t = (size_t)(t0 + 8 * r); id0[r] = IDX[t * 128 + lane]; id1[r] = IDX[t * 128 + 64 + lane];
                ha[r] = *(const u32x4*)(H8 + t * 1024 + 256 * x + 16 * c); hb[r] = *(const u32x4*)(H8 + t * 1024 + 256 * x + 128 + 16 * c); }
            g1_issue(uu[0], id0[0], id1[0], Ux, coff, g);
#pragma unroll
            for (int r = 0; r < PEER_TOK; ++r) { const int cur = r & 1;
                if (r + 1 < PEER_TOK) g1_issue(uu[cur ^ 1], id0[cur ^ 1], id1[cur ^ 1], Ux, coff, g);
                const u32x4 hac = ha[cur], hbc = hb[cur];
                if (r + 2 < PEER_TOK) { const size_t t = (size_t)(t0 + 8 * (r + 2)); id0[cur] = IDX[t * 128 + lane]; id1[cur] = IDX[t * 128 + 64 + lane];
                    ha[cur] = *(const u32x4*)(H8 + t * 1024 + 256 * x + 16 * c); hb[cur] = *(const u32x4*)(H8 + t * 1024 + 256 * x + 128 + 16 * c); }
                g1i_compute(uu[cur], hac, hbc, c, PARTx + (size_t)(t0 + 8 * r) * 128 + 2 * lane); } } }
}
__device__ __forceinline__ void phase_peer_g2(const Frame& F, const Params& p, const float* __restrict__ SUA, const float* __restrict__ GATE, const float* __restrict__ HS, const bf16_t* __restrict__ PART, unsigned char* __restrict__ ACT, int M) {
    const int lane = F.lane, g = lane >> 3, c = lane & 7, L0 = 8 * (c & 1) + 4 * ((c >> 1) & 1) + 2 * ((c >> 2) & 1);
    float* SA = (float*)(ACT + ACT_SA);
    const int stride = F.G * 8;
    for (int t0 = F.bid * 8 + F.wave; t0 < M; t0 += 2 * stride) {
        f32x2 s[2]; float hs[2], su[2][2], gt[2][2];
#pragma unroll
        for (int q = 0; q < 2; ++q) { const int t = t0 + q * stride; s[q] = (f32x2){0.f, 0.f};
            if (t < M) {
#pragma unroll
                for (int x = 0; x < 4; ++x) { const unsigned pv2 = *(const unsigned*)(PART + ((size_t)x * M + t) * 128 + 2 * lane); s[q] += (f32x2){bf_lo(pv2), bf_hi(pv2)}; }
                hs[q] = HS[t];
#pragma unroll
                for (int j = 0; j < 2; ++j) { const int k = 8 * (L0 + j) + g; su[q][j] = SUA[(size_t)t * 128 + k]; gt[q][j] = GATE[(size_t)t * 128 + k]; } } }
#pragma unroll
        for (int q = 0; q < 2; ++q) { const int t = t0 + q * stride;
            if (t < M) {
                float a[2];
#pragma unroll
                for (int j = 0; j < 2; ++j) { const float dv = s[q][j] * su[q][j] * hs[q]; a[j] = gt[q][j] * 0.5f * dv * (1.f + erff(dv * 0.70710678118654752f)); }
                float am = fmaxf(fabsf(a[0]), fabsf(a[1]));
#pragma unroll
                for (int o = 32; o; o >>= 1) am = fmaxf(am, __shfl_xor(am, o));
                const float sc = am > 0.f ? 119.f / am : 1.f;
                const int q0 = max(-119, min(119, __float2int_rn(a[0] * sc))), q1 = max(-119, min(119, __float2int_rn(a[1] * sc)));
                const int a0 = (q0 + 8) >> 4, b0 = q0 - 16 * a0, a1 = (q1 + 8) >> 4, b1 = q1 - 16 * a1;
                const unsigned w = ((unsigned)a0 & 15u) | (((unsigned)b0 & 15u) << 4) | (((unsigned)a1 & 15u) << 8) | (((unsigned)b1 & 15u) << 12);
                const unsigned pw = (unsigned)__shfl_down((int)w, 8);
                if ((g & 1) == 0) {
#pragma unroll
                    for (int j = 0; j < 2; ++j) { unsigned char* ap = ACT + (size_t)t * 128 + 4 * (L0 + j) + (g >> 1);
                        ap[0] = (unsigned char)(((w >> (8 * j)) & 15u) | (((pw >> (8 * j)) & 15u) << 4)); ap[64] = (unsigned char)(((w >> (8 * j + 4)) & 15u) | (((pw >> (8 * j + 4)) & 15u) << 4)); } }
                if (lane == 0) SA[t] = am > 0.f ? am * (1.f / 119.f) : 0.f; } }
    }
}
typedef int i32x4 __attribute__((ext_vector_type(4)));
typedef int i32x2 __attribute__((ext_vector_type(2)));
__device__ __forceinline__ void g3_dma16(i32x4 rs, unsigned ldsaddr, int voff) {
    asm volatile("s_mov_b32 m0, %0\n\tbuffer_load_dwordx4 %1, %2, 0 offen lds" :: "s"(ldsaddr), "v"(voff), "s"(rs) : "memory", "m0");
}
__device__ __forceinline__ void g3_dma4(i32x4 rs, unsigned ldsaddr, int voff) {
    asm volatile("s_mov_b32 m0, %0\n\tbuffer_load_dword %1, %2, 0 offen lds" :: "s"(ldsaddr), "v"(voff), "s"(rs) : "memory", "m0");
}
template <int N> __device__ __forceinline__ void g3_vmwait() { asm volatile("s_waitcnt vmcnt(%0)" :: "n"(N) : "memory"); }
__device__ __forceinline__ void g3_wait(int n) {
    switch (n) { case 4: g3_vmwait<4>(); break; case 8: g3_vmwait<8>(); break; case 12: g3_vmwait<12>(); break; case 14: g3_vmwait<14>(); break; default: g3_vmwait<0>(); break; }
}
__device__ __forceinline__ i32x4 g3_rsrc(const void* base, unsigned bytes) {
    const unsigned long long vb = (unsigned long long)base;
    return (i32x4){(int)__builtin_amdgcn_readfirstlane((unsigned)vb), (int)(__builtin_amdgcn_readfirstlane((unsigned)(vb >> 32)) & 0xffffu), (int)bytes, 0x00020000};
}
__device__ __forceinline__ void phase_peer_g3(const Frame& F, const Params& p, const u16* __restrict__ IDX, const unsigned char* __restrict__ ACT, bf16_t* __restrict__ OUT, int M, int qslot) {
    const unsigned char* V4 = p.ws + ((qslot & 2) ? WS_TAB1 : WS_TAB) + TAB_V8;
    unsigned* heads = (unsigned*)(p.ws + WS_CTL + WS_QUEUE) + (size_t)qslot * 8 * 64;
    const int nitems = M / (8 * PEER_TOK), myx = (int)(xb_xcc_id() & 3u), lane = F.lane, g = lane >> 3;
    const int wv = __builtin_amdgcn_readfirstlane(F.wave);
    LAS unsigned char* ring = F.lds + wv * 16384;
    const unsigned ringa = (unsigned)(size_t)ring;
    LAS unsigned char* tokb = F.lds + 131072 + wv * 1024;
    const unsigned tokba = (unsigned)(size_t)tokb;
    const i32x4 rsI = g3_rsrc(IDX, (unsigned)M * 256u), rsA = g3_rsrc(ACT, 16u << 20);
    const int aoffl = lane < 32 ? 4 * lane : (int)ACT_SA;
    const int coff0 = 16 * ((lane & 7) ^ (g >> 1)), coff1 = 16 * ((lane & 7) ^ ((g >> 1) | 4));
    const int gi = lane >> 4, l16 = lane & 15, swr = ((l16 & 7) >> 1) | ((l16 >> 3) << 2);
    int rdoff[4];
#pragma unroll
    for (int m = 0; m < 4; ++m) rdoff[m] = (l16 >> 3) * 1024 + (l16 & 7) * 128 + (((2 * m + (gi >> 1)) ^ swr) * 16) + (gi & 1) * 8;
#define G3_TOKEN_DMA(r_) do { const int t_ = t0 + 8 * (r_); g3_dma4(rsI, tokba + ((r_) & 1) * 512, t_ * 256 + 4 * lane); \
        g3_dma4(rsA, tokba + ((r_) & 1) * 512 + 256, lane < 32 ? t_ * 128 + aoffl : aoffl + 4 * t_); } while (0)
#define G3_QUAD_IDS(r_, qn_) do { _Pragma("unroll") for (int jj = 0; jj < 4; ++jj) en[jj] = *(const LAS u16*)(tokb + ((r_) & 1) * 512 + 2 * (8 * (4 * (qn_) + jj) + g)); } while (0)
#define G3_QUAD_DMA(qn_) do { _Pragma("unroll") for (int jj = 0; jj < 4; ++jj) g3_dma16(rs, ringa + (4 * (qn_) + jj) * 1024, en[jj] * 128 + ((jj & 1) ? coff1 : coff0)); } while (0)
    __builtin_amdgcn_s_waitcnt(0x0F70);
    for (int k = 0; k < 4; ++k) { const int x = (myx + k) & 3;
        const i32x4 rs = g3_rsrc(V4 + (size_t)x * TAB_SLICE, (unsigned)TAB_SLICE);
        int pending = 0, pv = 0;
        const int col = 256 * x + 64 * gi + 4 * l16;
        for (;;) { const int item = q_next(F, heads + x * 64, pv, pending); pv = 1; if (item >= nitems) break;
            const int t0 = item * 8 * PEER_TOK + F.wave;
            asm volatile("s_waitcnt lgkmcnt(0)" ::: "memory");
            G3_TOKEN_DMA(0); G3_TOKEN_DMA(1);
            g3_vmwait<3>();
            int en[4];
            G3_QUAD_IDS(0, 0); G3_QUAD_DMA(0); G3_QUAD_IDS(0, 1); G3_QUAD_DMA(1); G3_QUAD_IDS(0, 2); G3_QUAD_DMA(2); G3_QUAD_IDS(0, 3);
#pragma unroll
            for (int r = 0; r < PEER_TOK; ++r) {
                u32x4 A[8]; float sac = 0.f;
                int accA[4] = {0, 0, 0, 0}, accB[4] = {0, 0, 0, 0};
#pragma unroll
                for (int qq = 0; qq < 4; ++qq) { const int Q = 4 * r + qq;
                    asm volatile("s_waitcnt lgkmcnt(0)" ::: "memory");
                    if (qq == 1 && r + 2 < PEER_TOK) G3_TOKEN_DMA(r + 2);
                    if (Q + 3 < 4 * PEER_TOK) G3_QUAD_DMA((Q + 3) & 3);
                    { const int nq = (4 * PEER_TOK - 1 - Q) < 3 ? (4 * PEER_TOK - 1 - Q) : 3; g3_wait(4 * nq + ((qq >= 1 && r + 2 < PEER_TOK) ? 2 : 0)); }
                    if (Q + 4 < 4 * PEER_TOK) G3_QUAD_IDS((Q + 4) >> 2, (Q + 4) & 3);
                    if (qq == 0) {
#pragma unroll
                        for (int i = 0; i < 8; ++i) A[i] = *(const LAS u32x4*)(tokb + (r & 1) * 512 + 256 + 16 * i);
                        sac = *(const LAS float*)(tokb + (r & 1) * 512 + 384); }
#pragma unroll
                    for (int ss = 0; ss < 2; ++ss) { const int s = 2 * qq + ss;
                        const int aA0 = (int)A[(2 * s) >> 2][(2 * s) & 3], aA1 = (int)A[(2 * s + 1) >> 2][(2 * s + 1) & 3], aB0 = (int)A[4 + ((2 * s) >> 2)][(2 * s) & 3], aB1 = (int)A[4 + ((2 * s + 1) >> 2)][(2 * s + 1) & 3];
#pragma unroll
                        for (int m = 0; m < 4; ++m) {
                            const i32x2 d = __builtin_amdgcn_ds_read_tr4_b64_v2i32((LAS i32x2*)(ring + s * 2048 + rdoff[m]));
                            accA[m] = __builtin_amdgcn_sdot8(d[0], aA0, accA[m], false); accA[m] = __builtin_amdgcn_sdot8(d[1], aA1, accA[m], false);
                            accB[m] = __builtin_amdgcn_sdot8(d[0], aB0, accB[m], false); accB[m] = __builtin_amdgcn_sdot8(d[1], aB1, accB[m], false); } }
                }
                *(u32x2*)(OUT + (size_t)(t0 + 8 * r) * 1024 + col) = (u32x2){pk_bf16(sac * (float)(16 * accA[0] + accB[0]), sac * (float)(16 * accA[1] + accB[1])),
                                                                              pk_bf16(sac * (float)(16 * accA[2] + accB[2]), sac * (float)(16 * accA[3] + accB[3]))};
            } } }
#undef G3_TOKEN_DMA
#undef G3_QUAD_DMA
#undef G3_QUAD_IDS
}
__device__ __forceinline__ void phase_final_norm(const Frame& F, const Params& p, const bf16_t* __restrict__ R, const bf16_t* __restrict__ OUT, const float* __restrict__ g5base) {
    f32x4 wv4[4];
#pragma unroll
    for (int i = 0; i < 4; ++i) wv4[i] = *(const f32x4*)(p.in[8] + 256 * i + 4 * F.lane);
    const int stride = F.G * 8;
    for (int row0 = F.bid * 8 + F.wave; row0 < ML; row0 += 2 * stride) {
        u32x2 rv[2][4], ov[2][4]; f32x4 gv[2][4];
#pragma unroll
        for (int q = 0; q < 2; ++q) { const int row = row0 + q * stride;
            if (row < ML) { const bf16_t* sp = R + (size_t)row * 1024; const bf16_t* op = OUT + (size_t)row * 1024; const float* gp = g5base + (size_t)(row >> 12) * 6144;
#pragma unroll
                for (int i = 0; i < 4; ++i) { const int col = 256 * i + 4 * F.lane; rv[q][i] = *(const u32x2*)(sp + col); ov[q][i] = *(const u32x2*)(op + col); gv[q][i] = *(const f32x4*)(gp + col); } } }
#pragma unroll
        for (int q = 0; q < 2; ++q) { const int row = row0 + q * stride;
            if (row < ML) {
                f32x4 x[4]; float ss = 0.f;
#pragma unroll
                for (int i = 0; i < 4; ++i) { const u32x2 r2 = rv[q][i], o = ov[q][i]; const f32x4 g5 = gv[q][i];
                    x[i] = (f32x4){bf_lo(r2[0]) + g5[0] * bf_lo(o[0]), bf_hi(r2[0]) + g5[1] * bf_hi(o[0]), bf_lo(r2[1]) + g5[2] * bf_lo(o[1]), bf_hi(r2[1]) + g5[3] * bf_hi(o[1])};
                    ss += x[i][0] * x[i][0] + x[i][1] * x[i][1] + x[i][2] * x[i][2] + x[i][3] * x[i][3]; }
                ss = wave_sum(ss);
                const float rs = rsqrtf(ss * (1.f / 1024.f) + NORM_EPS);
#pragma unroll
                for (int i = 0; i < 4; ++i) { const int col = 256 * i + 4 * F.lane; const f32x4 wv = wv4[i];
                    *(f32x4*)(p.out + (size_t)row * 1024 + col) = (f32x4){x[i][0] * rs * wv[0], x[i][1] * rs * wv[1], x[i][2] * rs * wv[2], x[i][3] * rs * wv[3]}; } } }
    }
}

constexpr int GL_STR = 288, GL_VSTR = 144;
constexpr int GL_QG = 0, GL_KG = 64 * GL_STR, GL_V = 2 * 64 * GL_STR, GL_SET = GL_V + 64 * GL_VSTR;
constexpr int GL_ST = 2 * GL_SET, GL_AM = GL_ST + 2 * 16384, GL_DEC = GL_AM + 4 * 2048, GL_END = GL_DEC + 2 * 512;
static_assert(GL_END <= LDS_MISC, "GLA LDS map");
struct GlaRegs { u32x4 qv[2], gv[2], vv; };
__device__ __forceinline__ void gla_load(GlaRegs& R, const bf16_t* __restrict__ PA, int r0, int hg, int d, int vh, int tid, int lane, int wave) {
    const int t = d ? 63 - lane : lane; const bf16_t* rp = PA + (size_t)(r0 + t) * 4096; const int rot = 64 * ((r0 + t) & 15), c0 = hg * 128 + 16 * wave;
#pragma unroll
    for (int i = 0; i < 2; ++i) { R.qv[i] = *(const u32x4*)(rp + ((c0 + 8 * i + rot) & 4095)); R.gv[i] = *(const u32x4*)(rp + ((c0 + 1024 + d * 1024 + 8 * i + rot) & 4095)); }
    { const int rv = r0 + (tid >> 3); R.vv = *(const u32x4*)(PA + (size_t)rv * 4096 + ((3072 + hg * 128 + vh * 64 + (tid & 7) * 8 + 64 * (rv & 15)) & 4095)); }
}
__device__ __forceinline__ void gla_stage(LAS unsigned char* lds, const GlaRegs& R, int set, int d, int tid, int lane, int wave) {
    const int sb = set * GL_SET, t = d ? 63 - lane : lane, kb = 16 * wave;
    float gc[16], kk[16], qq[16];
#pragma unroll
    for (int i = 0; i < 2; ++i)
#pragma unroll
        for (int e = 0; e < 8; ++e) { const float g = bf_one(dw_elem(R.gv[i], e)); kk[8 * i + e] = 1.f - __builtin_amdgcn_exp2f(g); qq[8 * i + e] = bf_one(dw_elem(R.qv[i], e)); gc[8 * i + e] = wave_incl_scan(g); }
    float qg[16], kg[16], ee[16];
#pragma unroll
    for (int c = 0; c < 16; ++c) { ee[c] = __builtin_amdgcn_exp2f(gc[c]); qg[c] = qq[c] * ee[c]; kg[c] = kk[c] * __builtin_amdgcn_exp2f(-gc[c]); }
#pragma unroll
    for (int i = 0; i < 2; ++i) {
        *(LAS u32x4*)(lds + sb + GL_QG + t * GL_STR + ((kb >> 3) + i) * 16) = (u32x4){pk_bf16(qg[8 * i], qg[8 * i + 1]), pk_bf16(qg[8 * i + 2], qg[8 * i + 3]), pk_bf16(qg[8 * i + 4], qg[8 * i + 5]), pk_bf16(qg[8 * i + 6], qg[8 * i + 7])};
        *(LAS u32x4*)(lds + sb + GL_KG + t * GL_STR + ((kb >> 3) + i) * 16) = (u32x4){pk_bf16(kg[8 * i], kg[8 * i + 1]), pk_bf16(kg[8 * i + 2], kg[8 * i + 3]), pk_bf16(kg[8 * i + 4], kg[8 * i + 5]), pk_bf16(kg[8 * i + 6], kg[8 * i + 7])}; }
    if (lane == 63) {
#pragma unroll
        for (int i = 0; i < 4; ++i) *(LAS f32x4*)(lds + GL_DEC + set * 512 + (kb + 4 * i) * 4) = (f32x4){ee[4 * i], ee[4 * i + 1], ee[4 * i + 2], ee[4 * i + 3]};
    }
    *(LAS u32x4*)(lds + sb + GL_V + (tid >> 3) * GL_VSTR + (tid & 7) * 16) = R.vv;
}
__device__ __forceinline__ void gla_compute(LAS unsigned char* lds, int set, int d, bool lat, f32x4 (&S)[4], int r0, int hg, int vh, bf16_t* O, int lane, int wave) {
    const int sb = set * GL_SET, fr = lane & 15, fq = lane >> 4, tt = wave >> 1, vp = wave & 1;
    const int t = 16 * tt + fr;
    f32x4 oacc[2] = {{0.f, 0.f, 0.f, 0.f}, {0.f, 0.f, 0.f, 0.f}};
    if (lat) {
        bf16x8 qgf[4], stf[2][4];
#pragma unroll
        for (int ks = 0; ks < 4; ++ks) qgf[ks] = ld_row(lds, sb + GL_QG, GL_STR, tt, ks, lane);
        f32x4 aacc[4] = {{0.f, 0.f, 0.f, 0.f}, {0.f, 0.f, 0.f, 0.f}, {0.f, 0.f, 0.f, 0.f}, {0.f, 0.f, 0.f, 0.f}};
#pragma unroll
        for (int sh = 0; sh < 2; ++sh) {
            bf16x8 kgf[2][4];
#pragma unroll
            for (int si = 0; si < 2; ++si)
#pragma unroll
                for (int ks = 0; ks < 4; ++ks) kgf[si][ks] = ld_row(lds, sb + GL_KG, GL_STR, 2 * sh + si, ks, lane);
            __builtin_amdgcn_sched_barrier(0);
#pragma unroll
            for (int ks = 0; ks < 4; ++ks)
#pragma unroll
                for (int si = 0; si < 2; ++si) aacc[2 * sh + si] = mfma16(kgf[si][ks], qgf[ks], aacc[2 * sh + si]);
            __builtin_amdgcn_sched_barrier(0);
        }
#pragma unroll
        for (int vs = 0; vs < 2; ++vs)
#pragma unroll
            for (int ks = 0; ks < 4; ++ks) stf[vs][ks] = ld_frag(lds, GL_ST + set * 16384, 2 * vp + vs, ks, 4, lane);
        __builtin_amdgcn_sched_barrier(0);
#pragma unroll
        for (int ks = 0; ks < 4; ++ks)
#pragma unroll
            for (int vs = 0; vs < 2; ++vs) oacc[vs] = mfma16(stf[vs][ks], qgf[ks], oacc[vs]);
#pragma unroll
        for (int si = 0; si < 4; ++si) { const int s0 = 16 * si + 4 * fq; float v[4];
#pragma unroll
            for (int j = 0; j < 4; ++j) { const int s = s0 + j; const bool ok = d ? (s >= t) : (s <= t); v[j] = ok ? aacc[si][j] : 0.f; }
            *(LAS u32x2*)(lds + GL_AM + tt * 2048 + frag_off(fr, s0 >> 3, 2) + (s0 & 7) * 2) = (u32x2){pk_bf16(v[0], v[1]), pk_bf16(v[2], v[3])}; }
    }
    __builtin_amdgcn_sched_barrier(0);
    bf16x8 ktf[2], vtf[4][2];
#pragma unroll
    for (int ks = 0; ks < 2; ++ks) { ktf[ks] = ld_tr(lds, sb + GL_KG, GL_STR, ks, 16 * wave, lane);
#pragma unroll
        for (int vt = 0; vt < 4; ++vt) vtf[vt][ks] = ld_tr(lds, sb + GL_V, GL_VSTR, ks, 16 * vt, lane); }
    const f32x4 dec = *(LAS f32x4*)(lds + GL_DEC + set * 512 + (16 * wave + 4 * fq) * 4);
    __builtin_amdgcn_sched_barrier(0);
#pragma unroll
    for (int ks = 0; ks < 2; ++ks)
#pragma unroll
        for (int vt = 0; vt < 4; ++vt) S[vt] = mfma16(ktf[ks], vtf[vt][ks], S[vt]);
#pragma unroll
    for (int vt = 0; vt < 4; ++vt) { S[vt][0] *= dec[0]; S[vt][1] *= dec[1]; S[vt][2] *= dec[2]; S[vt][3] *= dec[3]; }
    if (lat) {
        bf16x8 amf[2], vof[2][2];
#pragma unroll
        for (int ks = 0; ks < 2; ++ks) { amf[ks] = ld_frag(lds, GL_AM + tt * 2048, 0, ks, 2, lane);
#pragma unroll
            for (int vs = 0; vs < 2; ++vs) vof[vs][ks] = ld_tr(lds, sb + GL_V, GL_VSTR, ks, 16 * (2 * vp + vs), lane); }
        __builtin_amdgcn_sched_barrier(0);
#pragma unroll
        for (int ks = 0; ks < 2; ++ks)
#pragma unroll
            for (int vs = 0; vs < 2; ++vs) oacc[vs] = mfma16(vof[vs][ks], amf[ks], oacc[vs]);
        bf16_t* op = O + (size_t)(r0 + t) * 1024 + ((hg * 128 + vh * 64 + (d ? 512 : 0)) & 1023) + 32 * vp + 4 * fq;
#pragma unroll
        for (int vs = 0; vs < 2; ++vs) *(u32x2*)(op + 16 * vs) = (u32x2){pk_bf16(oacc[vs][0], oacc[vs][1]), pk_bf16(oacc[vs][2], oacc[vs][3])};
    }
    { const int k0 = 16 * wave + 4 * fq;
#pragma unroll
      for (int vt = 0; vt < 4; ++vt) *(LAS u32x2*)(lds + GL_ST + (set ^ 1) * 16384 + frag_off(16 * vt + fr, k0 >> 3, 4) + (k0 & 7) * 2) = (u32x2){pk_bf16(S[vt][0], S[vt][1]), pk_bf16(S[vt][2], S[vt][3])}; }
}
__device__ __forceinline__ void phase_gla(const Frame& F, const Params& p) {
    LAS unsigned char* lds = F.lds;
    const bf16_t* PA = (const bf16_t*)(p.ws + WS_PA);
    const int tid = F.tid, lane = F.lane, wave = F.wave, fr = lane & 15, fq = lane >> 4;
    const int tt = wave >> 1, vp = wave & 1;
    for (int u = F.bid; u < 256; u += F.G) {
        const int b = u >> 5, hg = (u >> 2) & 7, d = (u >> 1) & 1, vh = u & 1;
        bf16_t* O = (bf16_t*)((unsigned char*)p.out + (d ? DO_Y1 : 0));
        for (int i = tid; i < 1024; i += 512) *(LAS u32x4*)(lds + GL_ST + i * 16) = (u32x4){0u, 0u, 0u, 0u};
        f32x4 S[4];
#pragma unroll
        for (int i = 0; i < 4; ++i) S[i] = (f32x4){0.f, 0.f, 0.f, 0.f};
        GlaRegs R;
        gla_load(R, PA, chunk_row0(0, b, d), hg, d, vh, tid, lane, wave);
        gla_stage(lds, R, 0, d, tid, lane, wave);
        gla_load(R, PA, chunk_row0(1, b, d), hg, d, vh, tid, lane, wave);
        __syncthreads();
        for (int q = 0; q < 68; ++q) {
            const int set = q & 1, sb = set * GL_SET, r0 = chunk_row0(q, b, d); const bool lat = q >= 4;
            if (q + 1 < 68) gla_stage(lds, R, set ^ 1, d, tid, lane, wave);
            if (q + 2 < 68) gla_load(R, PA, chunk_row0(q + 2, b, d), hg, d, vh, tid, lane, wave);
            gla_compute(lds, set, d, lat, S, r0, hg, vh, O, lane, wave);
            __syncthreads();
        }
    }
}

__device__ __forceinline__ void phase_finish1(const Frame& F, const Params& p) {
    const bf16_t* O0 = (const bf16_t*)p.out; const bf16_t* O1 = (const bf16_t*)((const unsigned char*)p.out + DO_Y1);
    const bf16_t* SG = (const bf16_t*)(p.ws + WS_SG); bf16_t* A1 = (bf16_t*)(p.ws + WS_A1);
    const int c0 = F.lane * 16;
    f32x4 gn[4];
#pragma unroll
    for (int q = 0; q < 4; ++q) gn[q] = *(const f32x4*)(p.in[21] + c0 + 4 * q);
    const int stride = F.G * 8;
    for (int row0 = F.bid * 8 + F.wave; row0 < ML; row0 += 2 * stride) {
        u32x4 la[2][2], lb[2][2], ls[2][2];
#pragma unroll
        for (int q = 0; q < 2; ++q) { const int row = row0 + q * stride;
            if (row < ML) { const size_t o = (size_t)row * 1024 + c0;
#pragma unroll
                for (int i = 0; i < 2; ++i) { la[q][i] = *(const u32x4*)(O0 + o + 8 * i); lb[q][i] = *(const u32x4*)(O1 + (size_t)row * 1024 + ((c0 + 512) & 1023) + 8 * i); ls[q][i] = *(const u32x4*)(SG + o + 8 * i); } } }
#pragma unroll
        for (int q = 0; q < 2; ++q) { const int row = row0 + q * stride;
            if (row < ML) { const size_t o = (size_t)row * 1024 + c0;
                float v[16], sg[16]; float ss = 0.f;
#pragma unroll
                for (int i = 0; i < 2; ++i) { const u32x4 a = la[q][i], bq = lb[q][i], s = ls[q][i];
#pragma unroll
                    for (int e = 0; e < 8; ++e) { const float x = bf_one(dw_elem(a, e)) + bf_one(dw_elem(bq, e)); v[8 * i + e] = x; ss += x * x; sg[8 * i + e] = bf_one(dw_elem(s, e)); } }
                ss += __shfl_xor(ss, 1); ss += __shfl_xor(ss, 2); ss += __shfl_xor(ss, 4);
                const float rs = rsqrtf(ss * (1.f / 128.f) + NORM_EPS);
                float w[16]; float am = 0.f;
#pragma unroll
                for (int i = 0; i < 2; ++i) { const f32x4 g0 = gn[2 * i], g1 = gn[2 * i + 1];
#pragma unroll
                    for (int e = 0; e < 4; ++e) { w[8 * i + e] = v[8 * i + e] * rs * g0[e] * sg[8 * i + e]; w[8 * i + 4 + e] = v[8 * i + 4 + e] * rs * g1[e] * sg[8 * i + 4 + e]; } }
#pragma unroll
                for (int e = 0; e < 16; ++e) am = fmaxf(am, fabsf(w[e]));
#pragma unroll
                for (int ofs = 32; ofs; ofs >>= 1) am = fmaxf(am, __shfl_xor(am, ofs));
                const float s7 = am > 0.f ? 127.f / am : 1.f;
                u32x4 oq;
#pragma unroll
                for (int i = 0; i < 4; ++i) oq[i] = pack_i8x4((f32x4){w[4 * i], w[4 * i + 1], w[4 * i + 2], w[4 * i + 3]}, s7);
                *(u32x4*)((unsigned char*)A1 + (size_t)row * 1024 + c0) = oq;
                if (F.lane == 0) ((float*)(p.ws + WS_AS2))[row] = am > 0.f ? am * (1.f / 127.f) : 1.f; } }
    }
}

struct OneUnit { int pm, pn;
    __device__ bool next(int i, pg8::Unit& u) const { if (i != 0) return false; u.pm = pm; u.pn = pn; return true; }
    __device__ __forceinline__ void a_ready(const pg8::Unit&) const {}
    __device__ __forceinline__ void done(const pg8::Unit&) const {} };
constexpr int N_PHASES = 25;
#ifndef MK_ONE_LAUNCH
#define MK_ONE_LAUNCH 1
#endif
__global__ void __launch_bounds__(512, 2) fwd_kernel(Params p) {
    extern __shared__ __attribute__((aligned(16))) unsigned char lds_raw[];
    Frame F; F.lds = (LAS unsigned char*)lds_raw; F.tid = threadIdx.x; F.lane = F.tid & 63; F.wave = __builtin_amdgcn_readfirstlane(F.tid >> 6); F.bid = blockIdx.x; F.G = gridDim.x;
    volatile LAS unsigned* MISC = (volatile LAS unsigned*)(F.lds + LDS_MISC);
    if (F.tid < 4) MISC[F.tid] = 0u;
    __syncthreads();
    XcdBarrier bar = xcd_barrier_post((unsigned*)(p.ws + WS_CTL), MISC);
    const int lo = p.ph_lo, hi = p.ph_hi;
    unsigned char* ws = p.ws; unsigned char* dout = (unsigned char*)p.out;
    const float* MOD0 = (const float*)(ws + WS_MOD); const float* MOD1 = MOD0 + 9 * 6144;
    bf16_t* R = (bf16_t*)(ws + WS_R);
#define IN(k) (lo <= (k) && (k) < hi)
#define SEAM(k) do { if (IN((k) + 1)) xcd_barrier(bar); } while (0)
    if (IN(0)) { p0_prologue(F, p); SEAM(0); }
    if (IN(1)) { phase_norm<false>(F, p.in[0], p.in[2], MA, p.in[6], MOD0, 0, 1024, nullptr, dout + DO_H, (float*)(ws + WS_AS));
        weights_to_i8<1024>(F, (const bf16_t*)(ws + WS_WIN0), NIN0, ws + WS_W8IN0, (float*)(ws + WS_SB0)); weights_to_i8<1024>(F, (const bf16_t*)(ws + WS_WIN1), ODD_IN, ws + WS_W8IN1, (float*)(ws + WS_SB1));
        weights_to_i8<2048>(F, (const bf16_t*)(ws + WS_WOUT0), 1024, ws + WS_W8OUT0, (float*)(ws + WS_SBO0)); weights_to_i8<1024>(F, (const bf16_t*)(ws + WS_WOUT1), 1024, ws + WS_W8OUT1, (float*)(ws + WS_SBO1));
        weights_to_i8<1024>(F, (const bf16_t*)(ws + WS_WQ), 4096, ws + WS_W8Q, (float*)(ws + WS_SBQ)); SEAM(1); }
    if (IN(2)) { pg8::Gemm g{(const bf16_t*)(dout + DO_H), (const bf16_t*)(ws + WS_W8IN0), MA, NIN0, 512};   pg8::StaticOrder S; S.init(MA, NIN0, F.G, F.bid);
        EpiIn0 E{(bf16_t*)(ws + WS_XBC), (bf16_t*)(ws + WS_P4), (float*)(ws + WS_DT), (const float*)(ws + WS_AS), (const float*)(ws + WS_SB0)}; pg8::gemm_phase<EpiIn0, pg8::StaticOrder>(F.lds, g, S, E);
        convert_tables_dyn(F, p, 0, (unsigned*)(ws + WS_CTL + 61440 + 256 * p.rep), 0, 256); SEAM(2); }
    if (IN(3)) { phase_conv(F, p); SEAM(3); }
    if (IN(4)) { phase_ssd(F, p); SEAM(4); }
    if (IN(5)) {
        if (F.G >= 64 && F.bid < 32) {
            const int panel = F.bid >> 2;
            phase_finish0(F, p, ML + 256 * panel + F.wave, ML + 256 * panel + 256, 8);
            asm volatile("s_waitcnt vmcnt(0)" ::: "memory"); __syncthreads();
            pg8::Gemm g{(const bf16_t*)(ws + WS_A2), (const bf16_t*)(ws + WS_W8OUT0), MA, 1024, 1024}; OneUnit S1{128 + panel, F.bid & 3};
            EpiResT<false> E{p.in[0], p.in[2], R, MOD0 + 2048, (const float*)(ws + WS_AS2), (const float*)(ws + WS_SBO0)}; pg8::gemm_phase<EpiResT<false>, OneUnit>(F.lds, g, S1, E);
        } else {
            const int nb = F.G >= 64 ? F.G - 32 : F.G, b0 = F.G >= 64 ? F.bid - 32 : F.bid;
            phase_finish0(F, p, b0 * 8 + F.wave, F.G >= 64 ? ML : MA, nb * 8);
        }
        SEAM(5); }
    if (IN(6)) { const int m6 = F.G >= 64 ? ML : MA; pg8::Gemm g{(const bf16_t*)(ws + WS_A2), (const bf16_t*)(ws + WS_W8OUT0), m6, 1024, 1024}; pg8::StaticOrder S; S.init(m6, 1024, F.G, F.bid);
        EpiResT<false> E{p.in[0], p.in[2], R, MOD0 + 2048, (const float*)(ws + WS_AS2), (const float*)(ws + WS_SBO0)}; pg8::gemm_phase<EpiResT<false>, pg8::StaticOrder>(F.lds, g, S, E); SEAM(6); }
    if (IN(7)) { phase_norm<true>(F, R, R, MA, p.in[7], MOD0, 3072, 4096, nullptr, ws + WS_H8_0, (float*)(ws + WS_HS_0), nullptr, nullptr, nullptr, dout + DO_H); SEAM(7); }
    if (IN(8)) { pg8::Gemm g{(const bf16_t*)(dout + DO_H), (const bf16_t*)(ws + WS_W8Q), MA, 2048, 512}; pg8::StaticOrder S; S.init(MA, 2048, F.G, F.bid);
        EpiBf E{(bf16_t*)(ws + WS_Q0), 2048, (const float*)(ws + WS_HS_0), (const float*)(ws + WS_SBQ)}; pg8::gemm_phase<EpiBf, pg8::StaticOrder>(F.lds, g, S, E);
        convert_tables_dyn(F, p, 0, (unsigned*)(ws + WS_CTL + 62464 + 256 * p.rep), 256, 256); SEAM(8); }
    if (IN(9)) { phase_topk(F, p, 0, (const bf16_t*)(ws + WS_Q0), MA, (u16*)(dout + DO_IDX0), (float*)(dout + DO_GATE0), (float*)(dout + DO_SU0)); SEAM(9); }
    if (IN(10)) { phase_peer_g1i(F, p, ws + WS_H8_0, (const u16*)(dout + DO_IDX0), (bf16_t*)(ws + WS_PART0), MA, 0 + 4 * p.rep); SEAM(10); }
    if (IN(11)) { phase_peer_g2(F, p, (const float*)(dout + DO_SU0), (const float*)(dout + DO_GATE0), (const float*)(ws + WS_HS_0), (const bf16_t*)(ws + WS_PART0), ws + WS_ACT0, MA); SEAM(11); }
    if (IN(12)) { phase_peer_g3(F, p, (const u16*)(dout + DO_IDX0), ws + WS_ACT0, (bf16_t*)(ws + WS_OUT0), MA, 1 + 4 * p.rep); SEAM(12); }
    if (IN(13)) { phase_norm<true>(F, R, R, MA, p.in[6] + 1024, MOD1, 0, 1024, nullptr, dout + DO_H, (float*)(ws + WS_AS), (const bf16_t*)(ws + WS_OUT0), MOD0 + 5 * 1024, R); SEAM(13); }
    if (IN(14)) { pg8::Gemm g{(const bf16_t*)(dout + DO_H), (const bf16_t*)(ws + WS_W8IN1), MA, ODD_IN, 512}; pg8::StaticOrder S; S.init(MA, ODD_IN, F.G, F.bid);
        EpiIn1 E{(bf16_t*)(ws + WS_PA), (bf16_t*)(ws + WS_SG), (const float*)(ws + WS_LB), (const float*)(ws + WS_AS), (const float*)(ws + WS_SB1)}; pg8::gemm_phase<EpiIn1, pg8::StaticOrder>(F.lds, g, S, E);
        convert_tables_dyn(F, p, 1, (unsigned*)(ws + WS_CTL + 63488 + 512 * p.rep) + 64, 256, 256); SEAM(14); }
    if (IN(15)) { phase_gla(F, p); SEAM(15); }
    if (IN(16)) { phase_finish1(F, p); convert_tables_dyn(F, p, 1, (unsigned*)(ws + WS_CTL + 63488 + 512 * p.rep), 0, 256); SEAM(16); }
    if (IN(17)) { pg8::Gemm g{(const bf16_t*)(ws + WS_A1), (const bf16_t*)(ws + WS_W8OUT1), ML, 1024, 512}; pg8::StaticOrder S; S.init(ML, 1024, F.G, F.bid);
        unsigned* qh = (unsigned*)(ws + WS_CTL + 63488 + 512 * p.rep);
        EpiResT<true> E{nullptr, nullptr, R, MOD1 + 2048, (const float*)(ws + WS_AS2), (const float*)(ws + WS_SBO1)}; pg8::gemm_phase<EpiResT<true>, pg8::StaticOrder>(F.lds, g, S, E);
        convert_tables_dyn(F, p, 1, qh + 64, 256, 256);
        convert_tables_dyn(F, p, 1, qh, 0, 256);
        SEAM(17); }
    if (IN(18)) { phase_norm<true>(F, R, R, ML, p.in[7] + 1024, MOD1, 3072, 4096, nullptr, dout + DO_H8_1, (float*)(dout + DO_HS_1), nullptr, nullptr, nullptr, ws + WS_HF1); SEAM(18); }
    if (IN(19)) { pg8::Gemm g{(const bf16_t*)(ws + WS_HF1), (const bf16_t*)(ws + WS_W8Q + (size_t)2048 * 1024), ML, 2048, 512}; pg8::StaticOrder S; S.init(ML, 2048, F.G, F.bid);
        EpiBf E{(bf16_t*)(ws + WS_Q1), 2048, (const float*)(dout + DO_HS_1), (const float*)(ws + WS_SBQ) + 2048}; pg8::gemm_phase<EpiBf, pg8::StaticOrder>(F.lds, g, S, E); SEAM(19); }
    if (IN(20)) { phase_topk(F, p, 1, (const bf16_t*)(ws + WS_Q1), ML, (u16*)(ws + WS_IDX1), (float*)(ws + WS_GATE1), (float*)(ws + WS_SU1)); SEAM(20); }
    if (IN(21)) { phase_peer_g1i(F, p, dout + DO_H8_1, (const u16*)(ws + WS_IDX1), (bf16_t*)(ws + WS_PART1), ML, 2 + 4 * p.rep); SEAM(21); }
    if (IN(22)) { phase_peer_g2(F, p, (const float*)(ws + WS_SU1), (const float*)(ws + WS_GATE1), (const float*)(dout + DO_HS_1), (const bf16_t*)(ws + WS_PART1), ws + WS_ACT1, ML); SEAM(22); }
    if (IN(23)) { phase_peer_g3(F, p, (const u16*)(ws + WS_IDX1), ws + WS_ACT1, (bf16_t*)(ws + WS_OUT1), ML, 3 + 4 * p.rep); SEAM(23); }
    if (IN(24)) { phase_final_norm(F, p, R, (const bf16_t*)(ws + WS_OUT1), MOD1 + 5 * 1024); }
#undef IN
#undef SEAM
}


#ifdef DBG_STOP
__global__ void dump_kernel(const void* src, int is_f32, float* out, size_t n_src, size_t n) {
    for (size_t i = (size_t)blockIdx.x * blockDim.x + threadIdx.x; i < n; i += (size_t)gridDim.x * blockDim.x)
        out[i] = i < n_src ? (is_f32 ? ((const float*)src)[i] : __uint_as_float(((unsigned)((const unsigned short*)src)[i]) << 16)) : 0.f;
}
#endif
extern "C" void kernel_launch(void* const* d_in, const int* in_sizes, int n_in, void* d_out, int out_size, void* d_ws, size_t ws_size, hipStream_t stream) {
    static int grid = 0;
    if (grid == 0) {
        if (n_in != 26 || out_size != ML * D || ws_size < WS_END) { fprintf(stderr, "kernel_launch: unexpected problem (n_in %d, out %d, ws %zu < %zu)\n", n_in, out_size, ws_size, (size_t)WS_END); grid = -1; return; }
        int dev = 0, cus = 0, per_cu = 0;
        if (hipGetDevice(&dev) != hipSuccess || hipDeviceGetAttribute(&cus, hipDeviceAttributeMultiprocessorCount, dev) != hipSuccess) { grid = -1; return; }
        if (hipFuncSetAttribute((const void*)fwd_kernel, hipFuncAttributeMaxDynamicSharedMemorySize, LDS_BYTES) != hipSuccess) { fprintf(stderr, "kernel_launch: hipFuncSetAttribute failed\n"); grid = -1; return; }
        if (hipOccupancyMaxActiveBlocksPerMultiprocessor(&per_cu, (const void*)fwd_kernel, 512, LDS_BYTES) != hipSuccess || per_cu < 1) { fprintf(stderr, "kernel_launch: occupancy query says %d\n", per_cu); (void)hipGetLastError(); grid = -1; return; }
        grid = cus;
    }
    if (grid < 0) return;
    (void)hipMemsetAsync((char*)d_ws + WS_CTL, 0, CTL_BYTES, stream);
    Params p{};
    for (int i = 0; i < 26; ++i) p.in[i] = (const float*)d_in[i];
    p.out = (float*)d_out; p.ws = (unsigned char*)d_ws;
#if MK_ONE_LAUNCH
    p.ph_lo = 0; p.ph_hi = N_PHASES;
    hipLaunchKernelGGL(fwd_kernel, dim3(grid), dim3(512), LDS_BYTES, stream, p);
#elif defined(DBG_STOP)
    for (int k = 0; k <= DBG_STOP; ++k) { p.ph_lo = k; p.ph_hi = k + 1; hipLaunchKernelGGL(fwd_kernel, dim3(grid), dim3(512), LDS_BYTES, stream, p); }
    hipLaunchKernelGGL(dump_kernel, dim3(2048), dim3(256), 0, stream, (const void*)((unsigned char*)d_ws + DBG_SRC), DBG_F32, (float*)d_out, (size_t)DBG_N, (size_t)ML * D);
#else
    for (int k = 0; k < N_PHASES; ++k) { p.ph_lo = k; p.ph_hi = k + 1; hipLaunchKernelGGL(fwd_kernel, dim3(grid), dim3(512), LDS_BYTES, stream, p);
#ifdef DBG_REPMASK
        if ((DBG_REPMASK >> k) & 1) { p.rep = 1; hipLaunchKernelGGL(fwd_kernel, dim3(grid), dim3(512), LDS_BYTES, stream, p); p.rep = 0; }
#endif
    }
#endif
}
```
